# Optimizing an MI355X kernel written in HIP

```python
import jax, jax.numpy as jnp
from jax import lax
import numpy as np


D_MODEL = 1024
BATCH = 32
SEQ = 2048
DEPTH = 2

GRID_W = 64
CTX_LEN = 256
N_MIXERS = 2
N_ATT_LAYERS = (DEPTH + 1) // 2
N_MLSTM_LAYERS = DEPTH // 2
ATT_HEADS = 8
ATT_KV_HEADS = 2
ATT_GROUP = ATT_HEADS // ATT_KV_HEADS
ATT_HEAD_DIM = D_MODEL // ATT_HEADS
ROPE_PAIRS_PER_AXIS = ATT_HEAD_DIM // 4
ROPE_THETA = 10000.0
Q_BLOCK = 128
MLSTM_HEADS = 4
MLSTM_V_DIM = D_MODEL // MLSTM_HEADS
MLSTM_QK_DIM = MLSTM_V_DIM // 2
MLSTM_CONV_W = 3
MLSTM_CHUNK = 64
D_FF = 2816
N_MOD = 9
DEEPNORM_ALPHA = (2.0 * DEPTH) ** 0.25
DEEPNORM_BETA = (8.0 * DEPTH) ** -0.25
LN_EPS = 1e-5
RMS_EPS = 1e-6

kernel_name = "hybrid_gqa_mlstm_macaron_dit"


def layer_norm(x, g, b):
    xf = x.astype(jnp.float32)
    mu = jnp.mean(xf, axis=-1, keepdims=True)
    var = jnp.mean(jnp.square(xf - mu), axis=-1, keepdims=True)
    return ((xf - mu) * lax.rsqrt(var + LN_EPS) * g + b).astype(x.dtype)


def rms_norm(x, g):
    xf = x.astype(jnp.float32)
    return (xf * lax.rsqrt(jnp.mean(jnp.square(xf), axis=-1, keepdims=True) + RMS_EPS) * g).astype(x.dtype)


def modulate(h, shift, scale):
    return h * (1.0 + scale) + shift


def post_norm(h, delta, g, b):
    return layer_norm(DEEPNORM_ALPHA * h + delta, g, b)


def half_ffn(h, shift, scale, gate, w_in, w_out, g, b):
    xm = modulate(h, shift, scale)
    a, u = jnp.split(xm @ w_in, 2, axis=-1)
    y = (jax.nn.silu(a) * u) @ w_out
    return post_norm(h, 0.5 * gate * y, g, b)


def axial_rope_tables(n_tokens):
    rows = n_tokens // GRID_W
    row = jnp.repeat(jnp.arange(rows, dtype=jnp.int32), GRID_W).astype(jnp.float32)
    col = jnp.tile(jnp.arange(GRID_W, dtype=jnp.int32), rows).astype(jnp.float32)
    inv = ROPE_THETA ** (-jnp.arange(ROPE_PAIRS_PER_AXIS, dtype=jnp.float32) / ROPE_PAIRS_PER_AXIS)
    ang = jnp.stack([row[:, None] * inv, col[:, None] * inv], axis=1)
    return jnp.cos(ang), jnp.sin(ang)


def apply_rope(x, cos, sin):
    B, L, H, Dh = x.shape
    xr = x.reshape(B, L, H, 2, 2, ROPE_PAIRS_PER_AXIS)
    x1, x2 = xr[..., 0, :], xr[..., 1, :]
    c = cos[None, :, None]
    s = sin[None, :, None]
    out = jnp.stack([x1 * c - x2 * s, x2 * c + x1 * s], axis=-2)
    return out.reshape(B, L, H, Dh).astype(x.dtype)


def gqa_softmax(q, k, v):
    s = jnp.einsum('bqhgd,bkhd->bhgqk', q, k).astype(jnp.float32) * (ATT_HEAD_DIM ** -0.5)
    p = jax.nn.softmax(s, axis=-1).astype(v.dtype)
    return jnp.einsum('bhgqk,bkhd->bqhgd', p, v)


def attention_mixer(xl, xc, cos, sin, w_in, q_gain, k_gain, w_out, need_ctx):
    def proj(xs):
        B, L, _ = xs.shape
        p = xs @ w_in
        q, k, v = jnp.split(p, [ATT_HEADS * ATT_HEAD_DIM, (ATT_HEADS + ATT_KV_HEADS) * ATT_HEAD_DIM], axis=-1)
        q = rms_norm(q.reshape(B, L, ATT_HEADS, ATT_HEAD_DIM), q_gain)
        k = rms_norm(k.reshape(B, L, ATT_KV_HEADS, ATT_HEAD_DIM), k_gain)
        v = v.reshape(B, L, ATT_KV_HEADS, ATT_HEAD_DIM)
        return q, k, v

    ql, kl, vl = proj(xl)
    qc, kc, vc = proj(xc)
    ql = apply_rope(ql, cos, sin)
    kl = apply_rope(kl, cos, sin)
    B, L = xl.shape[0], xl.shape[1]
    k_all = jnp.concatenate([kl, kc], axis=1)
    v_all = jnp.concatenate([vl, vc], axis=1)
    nb = L // Q_BLOCK
    qb = jnp.moveaxis(ql.reshape(B, nb, Q_BLOCK, ATT_KV_HEADS, ATT_GROUP, ATT_HEAD_DIM), 1, 0)
    ob = lax.map(lambda qblk: gqa_softmax(qblk, k_all, v_all), qb)
    o_lat = jnp.moveaxis(ob, 0, 1).reshape(B, L, D_MODEL) @ w_out
    o_ctx = None
    if need_ctx:
        Lc = xc.shape[1]
        oc = gqa_softmax(qc.reshape(B, Lc, ATT_KV_HEADS, ATT_GROUP, ATT_HEAD_DIM), kc, vc)
        o_ctx = oc.reshape(B, Lc, D_MODEL) @ w_out
    return o_lat, o_ctx


def centred_conv(a, w, b):
    L = a.shape[1]
    pad = MLSTM_CONV_W // 2
    ap = jnp.pad(a, ((0, 0), (pad, pad), (0, 0)))
    out = ap[:, 0:L] * w[0]
    for j in range(1, MLSTM_CONV_W):
        out = out + ap[:, j:j + L] * w[j]
    return out + b


def mlstm_scan(q, k, v, log_i, log_f, state):
    B, H, L, dk = q.shape
    dv = v.shape[-1]
    Lc = MLSTM_CHUNK
    nc = L // Lc

    def chunks(a):
        return jnp.moveaxis(a.reshape((B, H, nc, Lc) + a.shape[3:]), 2, 0)

    tri = jnp.tril(jnp.ones((Lc, Lc), dtype=bool))

    def step(carry, inp):
        C, n, m = carry
        qc, kc, vc, ic, fc = inp
        bcum = jnp.cumsum(fc, axis=-1)
        d = jnp.where(tri, bcum[..., :, None] - bcum[..., None, :] + ic[..., None, :], -jnp.inf)
        inter = m[..., None] + bcum
        m_t = jnp.maximum(inter, jnp.max(d, axis=-1))
        w_intra = jnp.exp(d - m_t[..., None])
        w_inter = jnp.exp(inter - m_t)
        s = jnp.einsum('bhtd,bhsd->bhts', qc, kc) * w_intra
        num = jnp.einsum('bhts,bhsv->bhtv', s, vc) + w_inter[..., None] * jnp.einsum('bhvd,bhtd->bhtv', C, qc)
        den = jnp.sum(s, axis=-1) + w_inter * jnp.einsum('bhd,bhtd->bht', n, qc)
        h = num / jnp.maximum(jnp.abs(den), jnp.exp(-m_t))[..., None]
        b_last = bcum[..., -1]
        d_last = b_last[..., None] - bcum + ic
        m_new = jnp.maximum(m + b_last, jnp.max(d_last, axis=-1))
        wk = jnp.exp(d_last - m_new[..., None])
        decay = jnp.exp(m + b_last - m_new)
        C_new = decay[..., None, None] * C + jnp.einsum('bhs,bhsv,bhsd->bhvd', wk, vc, kc)
        n_new = decay[..., None] * n + jnp.einsum('bhs,bhsd->bhd', wk, kc)
        return (C_new, n_new, m_new), h

    final, hs = lax.scan(step, state, (chunks(q), chunks(k), chunks(v), chunks(log_i), chunks(log_f)))
    h = jnp.moveaxis(hs, 0, 2).reshape(B, H, L, dv)
    return h, final


def mlstm_mixer(xl, xc, w_in, gate_b, conv_w, conv_b, norm_g, w_out, need_ctx):
    HQK = MLSTM_HEADS * MLSTM_QK_DIM
    HV = MLSTM_HEADS * MLSTM_V_DIM

    def proj(xs):
        B, L, _ = xs.shape
        p = xs @ w_in
        qk, v, o, g = jnp.split(p, [2 * HQK, 2 * HQK + HV, 2 * HQK + HV + D_MODEL], axis=-1)
        qk = jax.nn.silu(centred_conv(qk, conv_w, conv_b))
        q, k = jnp.split(qk, 2, axis=-1)

        def heads(a, dh):
            return jnp.transpose(a.reshape(B, L, MLSTM_HEADS, dh), (0, 2, 1, 3)).astype(jnp.float32)

        q = heads(q, MLSTM_QK_DIM)
        k = heads(k, MLSTM_QK_DIM) * (MLSTM_QK_DIM ** -0.5)
        v = heads(v, MLSTM_V_DIM)
        g = jnp.transpose((g.astype(jnp.float32) + gate_b).reshape(B, L, 4, MLSTM_HEADS), (2, 0, 3, 1))
        return q, k, v, g, o

    def zero_state(B):
        return (jnp.zeros((B, MLSTM_HEADS, MLSTM_V_DIM, MLSTM_QK_DIM), jnp.float32),
                jnp.zeros((B, MLSTM_HEADS, MLSTM_QK_DIM), jnp.float32),
                jnp.zeros((B, MLSTM_HEADS), jnp.float32))

    def flip(a):
        return jnp.flip(a, axis=2)

    def readout(h, o, dtype):
        B, H, L, dv = h.shape
        mu = jnp.mean(h, axis=-1, keepdims=True)
        var = jnp.mean(jnp.square(h - mu), axis=-1, keepdims=True)
        hn = (h - mu) * lax.rsqrt(var + LN_EPS)
        hn = jnp.transpose(hn, (0, 2, 1, 3)).reshape(B, L, D_MODEL) * norm_g
        return (hn * jax.nn.sigmoid(o.astype(jnp.float32))).astype(dtype) @ w_out

    ql, kl, vl, gl, ol = proj(xl)
    qc, kc, vc, gc, oc = proj(xc)
    B = xl.shape[0]
    hc_f, st_f = mlstm_scan(qc, kc, vc, gc[0], jax.nn.log_sigmoid(gc[1]), zero_state(B))
    hl_f, _ = mlstm_scan(ql, kl, vl, gl[0], jax.nn.log_sigmoid(gl[1]), st_f)
    hc_b, st_b = mlstm_scan(flip(qc), flip(kc), flip(vc), flip(gc[2]), jax.nn.log_sigmoid(flip(gc[3])), zero_state(B))
    hl_b, _ = mlstm_scan(flip(ql), flip(kl), flip(vl), flip(gl[2]), jax.nn.log_sigmoid(flip(gl[3])), st_b)
    o_lat = readout(hl_f + flip(hl_b), ol, xl.dtype)
    o_ctx = readout(hc_f + flip(hc_b), oc, xc.dtype) if need_ctx else None
    return o_lat, o_ctx


def setup_inputs(seed: int = 0) -> dict:
    key = jax.random.key(seed)
    ks = jax.random.split(key, 24)
    D = D_MODEL
    HQK = MLSTM_HEADS * MLSTM_QK_DIM
    HV = MLSTM_HEADS * MLSTM_V_DIM
    att_cols = (ATT_HEADS + 2 * ATT_KV_HEADS) * ATT_HEAD_DIM
    ml_cols = 2 * HQK + HV + D + 4 * MLSTM_HEADS

    def nrm(k, shape, scale):
        return jax.random.normal(k, shape, jnp.float32) * scale

    forget_b = jnp.linspace(3.0, 6.0, MLSTM_HEADS, dtype=jnp.float32)
    gnoise = nrm(ks[15], (N_MLSTM_LAYERS, 4, MLSTM_HEADS), 0.1)
    gate_b = gnoise + jnp.stack([jnp.zeros_like(forget_b), forget_b, jnp.zeros_like(forget_b), forget_b], axis=0)[None]
    return {
        "x": nrm(ks[0], (BATCH, SEQ, D), 1.0),
        "c": nrm(ks[1], (BATCH, D), 1.0),
        "ctx": nrm(ks[2], (BATCH, CTX_LEN, D), 1.0),
        "c_ctx": nrm(ks[3], (D,), 1.0),
        "ada_w": nrm(ks[4], (DEPTH, D, N_MOD * D), 0.5 * D ** -0.5),
        "ada_b": nrm(ks[5], (DEPTH, N_MOD * D), 0.02),
        "ln_g": 1.0 + nrm(ks[6], (DEPTH, 3, D), 0.02),
        "ln_b": nrm(ks[7], (DEPTH, 3, D), 0.02),
        "ffn_w_in": nrm(ks[8], (DEPTH, 2, D, 2 * D_FF), D ** -0.5),
        "ffn_w_out": nrm(ks[9], (DEPTH, 2, D_FF, D), DEEPNORM_BETA * D_FF ** -0.5),
        "att_w_in": nrm(ks[10], (N_ATT_LAYERS, D, att_cols), D ** -0.5),
        "att_q_gain": 1.0 + nrm(ks[11], (N_ATT_LAYERS, ATT_HEAD_DIM), 0.02),
        "att_k_gain": 1.0 + nrm(ks[12], (N_ATT_LAYERS, ATT_HEAD_DIM), 0.02),
        "att_w_out": nrm(ks[13], (N_ATT_LAYERS, D, D), DEEPNORM_BETA * D ** -0.5),
        "ml_w_in": nrm(ks[14], (N_MLSTM_LAYERS, D, ml_cols), D ** -0.5),
        "ml_gate_b": gate_b.reshape(N_MLSTM_LAYERS, 4 * MLSTM_HEADS),
        "ml_conv_w": nrm(ks[16], (N_MLSTM_LAYERS, MLSTM_CONV_W, 2 * HQK), MLSTM_CONV_W ** -0.5),
        "ml_conv_b": nrm(ks[17], (N_MLSTM_LAYERS, 2 * HQK), 0.02),
        "ml_norm_g": 1.0 + nrm(ks[18], (N_MLSTM_LAYERS, D), 0.02),
        "ml_w_out": nrm(ks[19], (N_MLSTM_LAYERS, D, D), DEEPNORM_BETA * D ** -0.5),
    }


def reference(x, c, ctx, c_ctx, ada_w, ada_b, ln_g, ln_b, ffn_w_in, ffn_w_out,
              att_w_in, att_q_gain, att_k_gain, att_w_out,
              ml_w_in, ml_gate_b, ml_conv_w, ml_conv_b, ml_norm_g, ml_w_out):
    n_lat = x.shape[1]
    cos, sin = axial_rope_tables(n_lat)
    h_lat, h_ctx = x, ctx
    for i in range(DEPTH):
        need_ctx = i < DEPTH - 1
        mod_lat = jnp.split((jax.nn.silu(c) @ ada_w[i] + ada_b[i])[:, None, :], N_MOD, axis=-1)
        mod_ctx = jnp.split((jax.nn.silu(c_ctx) @ ada_w[i] + ada_b[i])[None, None, :], N_MOD, axis=-1)
        h_lat = half_ffn(h_lat, mod_lat[0], mod_lat[1], mod_lat[2], ffn_w_in[i, 0], ffn_w_out[i, 0], ln_g[i, 0], ln_b[i, 0])
        h_ctx = half_ffn(h_ctx, mod_ctx[0], mod_ctx[1], mod_ctx[2], ffn_w_in[i, 0], ffn_w_out[i, 0], ln_g[i, 0], ln_b[i, 0])
        xm_lat = modulate(h_lat, mod_lat[3], mod_lat[4])
        xm_ctx = modulate(h_ctx, mod_ctx[3], mod_ctx[4])
        j = i // N_MIXERS
        if i % N_MIXERS == 0:
            o_lat, o_ctx = attention_mixer(xm_lat, xm_ctx, cos, sin, att_w_in[j], att_q_gain[j], att_k_gain[j],
                                           att_w_out[j], need_ctx)
        else:
            o_lat, o_ctx = mlstm_mixer(xm_lat, xm_ctx, ml_w_in[j], ml_gate_b[j], ml_conv_w[j], ml_conv_b[j],
                                       ml_norm_g[j], ml_w_out[j], need_ctx)
        h_lat = post_norm(h_lat, mod_lat[5] * o_lat, ln_g[i, 1], ln_b[i, 1])
        h_lat = half_ffn(h_lat, mod_lat[6], mod_lat[7], mod_lat[8], ffn_w_in[i, 1], ffn_w_out[i, 1], ln_g[i, 2], ln_b[i, 2])
        if need_ctx:
            h_ctx = post_norm(h_ctx, mod_ctx[5] * o_ctx, ln_g[i, 1], ln_b[i, 1])
            h_ctx = half_ffn(h_ctx, mod_ctx[6], mod_ctx[7], mod_ctx[8], ffn_w_in[i, 1], ffn_w_out[i, 1], ln_g[i, 2], ln_b[i, 2])
    return h_lat
```

```cpp
#include <hip/hip_runtime.h>
#include <hip/hip_bf16.h>
#include <hip/hip_cooperative_groups.h>
#include <cstdio>
#include <cstdint>
namespace cg = cooperative_groups;
namespace pg8 {
#define PG8_LAS __attribute__((address_space(3)))
typedef unsigned short bf16_t;
typedef short bf16x8 __attribute__((ext_vector_type(8)));
typedef float f32x4 __attribute__((ext_vector_type(4)));
typedef unsigned u32x4 __attribute__((ext_vector_type(4)));
constexpr int BM = 256, BK = 64, HALF = 128, HTB = HALF * BK * 2  , STAGE_BYTES = 8 * HTB, NXCD = 8, WGM = 8;

__host__ __device__ __forceinline__ int lds_byte(int r, int c) { const int st = (r >> 4) * 2 + (c >> 5), rr = r & 15, cc = c & 31, ob = rr * 64 + cc * 2; return st * 1024 + (ob ^ (((ob >> 9) & 1) << 5)); }
__host__ __device__ __forceinline__ void stage_rc(int b, int& R, int& C) { const int st = b / 1024, sb = b % 1024, swz = sb ^ (((sb >> 9) & 1) << 5); R = (st >> 1) * 16 + swz / 64; C = (st & 1) * 32 + (swz % 64) / 2; }
__host__ __device__ __forceinline__ int perm32(int rho) { const int n = rho >> 4, i = rho & 15; return 8 * (i >> 2) + 4 * n + (i & 3); }

struct Unit { int pm, pn; };
struct Gemm { const bf16_t* A; const bf16_t* Bt; int M, N, K; };

struct StaticOrder {
    int nM, nN, nwg, G, c;
    __host__ __device__ void init(int M, int N, int G_, int c_) { nM = M / BM; nN = N / BM; nwg = nM * nN; G = G_; c = c_; }
    __host__ __device__ bool next(int i, Unit& u) const {
        const long L = (long)i * G + c; if (L >= nwg) return false;
        int wgid = (int)L; { const int q = nwg / NXCD, r = nwg % NXCD, xcd = wgid % NXCD, off = wgid / NXCD; wgid = (xcd < r ? xcd * (q + 1) : r * (q + 1) + (xcd - r) * q) + off; }
        const int nig = WGM * nN, gid = wgid / nig, fm = gid * WGM, gsz = (nM - fm) < WGM ? (nM - fm) : WGM;
        u.pm = fm + ((wgid % nig) % gsz); u.pn = (wgid % nig) / gsz; return true;
    }
    __device__ __forceinline__ void a_ready(const Unit&) const {}
    __device__ __forceinline__ void done(const Unit&) const {}
};

__device__ __forceinline__ unsigned cvt_pk_bf16(float lo, float hi) { unsigned r; asm volatile("v_cvt_pk_bf16_f32 %0, %1, %2" : "=v"(r) : "v"(lo), "v"(hi)); return r; }
typedef float f32x2 __attribute__((ext_vector_type(2)));
__device__ __forceinline__ f32x2 gelu_pk(f32x2 v) {
    const f32x2 av = __builtin_elementwise_abs(v), d = av * 0.2316418882f + 1.0f;
    f32x2 t; t.x = __builtin_amdgcn_rcpf(d.x); t.y = __builtin_amdgcn_rcpf(d.y);
    f32x2 q = t * 0.5307027145f + (-0.7265760135f); q = q * t + 0.7107068705f; q = q * t + (-0.142248368f); q = q * t + 0.127414796f; q = q * t;
    const f32x2 s = (v * v) * (-0.72134752044f);
    f32x2 e; e.x = __builtin_amdgcn_exp2f(s.x); e.y = __builtin_amdgcn_exp2f(s.y);
    const f32x2 m = v * (q * e), r = v - m;
    f32x2 o; o.x = v.x < 0.f ? m.x : r.x; o.y = v.y < 0.f ? m.y : r.y; return o;
}

template <int ACT  > struct EpiBf16 {
    static constexpr bool PERM = true, AFTER_DRAIN = false; static_assert(ACT == 0 || ACT == 1, "EpiBf16: ACT is 0 (none) or 1 (gelu_pk)");
    bf16_t* O; int ldc; const float* bias; int split_cols; size_t split_stride; float scale0;
    __device__ __forceinline__ void operator()(const f32x4 (&acc)[2][2][4][2], const Unit& u, int wr, int wc, int fr, int fq) const {
        const int row0 = u.pm * BM + wr * 64 + fr; int colt = u.pn * BM; bf16_t* base = O;
        float sc = 1.f; if (split_cols) { const int t = colt / split_cols; base += (size_t)t * split_stride; colt -= t * split_cols; if (t == 0) sc = scale0; }
        const int col0 = colt + wc * 32 + 8 * fq, bcol0 = u.pn * BM + wc * 32 + 8 * fq;
        f32x4 bv[2][2];
#pragma unroll
        for (int bj = 0; bj < 2; ++bj)
#pragma unroll
            for (int n = 0; n < 2; ++n) bv[bj][n] = bias ? *(const f32x4*)(bias + bcol0 + bj * HALF + 4 * n) : (f32x4){0.f, 0.f, 0.f, 0.f};
#pragma unroll
        for (int ai = 0; ai < 2; ++ai)
#pragma unroll
            for (int m = 0; m < 4; ++m) { bf16_t* rowp = base + (size_t)(row0 + ai * HALF + m * 16) * ldc + col0;
#pragma unroll
                for (int bj = 0; bj < 2; ++bj) { f32x4 v0 = acc[ai][bj][m][0] + bv[bj][0], v1 = acc[ai][bj][m][1] + bv[bj][1];
                    if (ACT == 1) { f32x2 a = gelu_pk((f32x2){v0[0], v0[1]}), b = gelu_pk((f32x2){v0[2], v0[3]}), c = gelu_pk((f32x2){v1[0], v1[1]}), d = gelu_pk((f32x2){v1[2], v1[3]});
                        v0 = (f32x4){a.x, a.y, b.x, b.y}; v1 = (f32x4){c.x, c.y, d.x, d.y}; }
                    v0 = v0 * sc; v1 = v1 * sc; u32x4 w; w.x = cvt_pk_bf16(v0[0], v0[1]); w.y = cvt_pk_bf16(v0[2], v0[3]); w.z = cvt_pk_bf16(v1[0], v1[1]); w.w = cvt_pk_bf16(v1[2], v1[3]);
                    *(u32x4*)(rowp + bj * HALF) = w; } }
    }
};

struct PanelStats {
    unsigned* xbuf;
    unsigned* cnt;
    unsigned* tmo;
    int ntn; float eps;
    unsigned code;
    __device__ __forceinline__ bool run(const f32x4 (&v)[2][2][4][2], const Unit& u, int wr, int wc, int fr, int fq, PG8_LAS unsigned char* lds, int wid, int lane) const {
        typedef float f32x2v __attribute__((ext_vector_type(2)));
        PG8_LAS f32x2v* P = (PG8_LAS f32x2v*)lds;
        PG8_LAS f32x2v* S = (PG8_LAS f32x2v*)(lds + 8192);
        PG8_LAS unsigned* flag = (PG8_LAS unsigned*)(lds + 8192 + 2048);
#pragma unroll
        for (int ai = 0; ai < 2; ++ai)
#pragma unroll
            for (int m = 0; m < 4; ++m) {
                float s = 0.f;
#pragma unroll
                for (int bj = 0; bj < 2; ++bj)
#pragma unroll
                    for (int n = 0; n < 2; ++n) { const f32x4 x = v[ai][bj][m][n]; s += (x[0] + x[1]) + (x[2] + x[3]); }
                s += __shfl_xor(s, 16); s += __shfl_xor(s, 32);
                const float mw = s * (1.0f / 64.0f); float q = 0.f;
#pragma unroll
                for (int bj = 0; bj < 2; ++bj)
#pragma unroll
                    for (int n = 0; n < 2; ++n) { const f32x4 d = v[ai][bj][m][n] - mw; q += (d[0] * d[0] + d[1] * d[1]) + (d[2] * d[2] + d[3] * d[3]); }
                q += __shfl_xor(q, 16); q += __shfl_xor(q, 32);
                if (fq == 0) P[(ai * HALF + wr * 64 + m * 16 + fr) * 4 + wc] = (f32x2v){mw, q};
            }
        asm volatile("s_waitcnt lgkmcnt(0)" ::: "memory"); __builtin_amdgcn_s_barrier(); asm volatile("" ::: "memory");
#if defined(BROKEN_EXCHANGE_NO_WAIT)
#warning BROKEN CONTROL BUILD: the row-statistics exchange does not wait; results are wrong by design
        if (blockIdx.x >= 64) { const long long t0_ = clock64(); while (clock64() - t0_ < 60000) __builtin_amdgcn_s_sleep(8); }
#endif
        const int row = wid * 32 + (lane & 31);
        if (lane < 32) {
            const f32x2v a = P[row * 4 + 0], b = P[row * 4 + 1], c = P[row * 4 + 2], d = P[row * 4 + 3];
            const float mt = (a.x + b.x + c.x + d.x) * 0.25f;
            const float da = a.x - mt, db = b.x - mt, dc = c.x - mt, dd = d.x - mt;
            const float m2 = (a.y + b.y) + (c.y + d.y) + 64.0f * ((da * da + db * db) + (dc * dc + dd * dd));
            unsigned long long* slot = (unsigned long long*)xbuf + ((size_t)(u.pm * BM + row) * 4 + u.pn);
            __hip_atomic_store(slot, ((unsigned long long)__float_as_uint(m2) << 32) | __float_as_uint(mt), __ATOMIC_RELAXED, __HIP_MEMORY_SCOPE_AGENT);
        }
        asm volatile("s_waitcnt vmcnt(0)" ::: "memory");
        if (lane == 0) __hip_atomic_fetch_add(cnt + 64 * u.pm, 1u, __ATOMIC_RELAXED, __HIP_MEMORY_SCOPE_AGENT);
        if (wid == 0) {
            bool dead = false; const unsigned long long t0 = __builtin_amdgcn_s_memrealtime(); const unsigned want = 8u * (unsigned)ntn;
            for (;;) {
#if defined(BROKEN_EXCHANGE_NO_WAIT)
                break;
#endif
                if ((unsigned)__builtin_amdgcn_readfirstlane(__hip_atomic_load(cnt + 64 * u.pm, __ATOMIC_RELAXED, __HIP_MEMORY_SCOPE_AGENT)) >= want) break;
                if (__builtin_amdgcn_s_memrealtime() - t0 > 2000000ull) {
                    if (lane == 0) { unsigned expect = 0u; __hip_atomic_compare_exchange_strong(tmo + 1, &expect, code | (unsigned)(u.pm & 0xff), __ATOMIC_RELAXED, __ATOMIC_RELAXED, __HIP_MEMORY_SCOPE_AGENT);
                                     __hip_atomic_store(tmo, 1u, __ATOMIC_RELAXED, __HIP_MEMORY_SCOPE_AGENT); }
                    dead = true; break; }
                __builtin_amdgcn_s_sleep(2);
            }
            __builtin_amdgcn_fence(__ATOMIC_ACQUIRE, "agent");
            if (lane == 0) flag[0] = dead ? 1u : 0u;
        }
        asm volatile("s_waitcnt vmcnt(0) lgkmcnt(0)" ::: "memory"); __builtin_amdgcn_s_barrier(); asm volatile("" ::: "memory");
        const bool bad = flag[0] != 0u;
        if (lane < 32) {
            const unsigned long long* slot = (const unsigned long long*)xbuf + (size_t)(u.pm * BM + row) * 4; float mt[4], m2[4]; float ms = 0.f;
#pragma unroll
            for (int t = 0; t < 4; ++t) { if (t < ntn) { const unsigned long long w = __hip_atomic_load(slot + t, __ATOMIC_RELAXED, __HIP_MEMORY_SCOPE_AGENT); mt[t] = __uint_as_float((unsigned)w); m2[t] = __uint_as_float((unsigned)(w >> 32)); } else { mt[t] = 0.f; m2[t] = 0.f; } ms += mt[t]; }
            const float mean = ms / (float)ntn; float q = 0.f;
#pragma unroll
            for (int t = 0; t < 4; ++t) if (t < ntn) { const float dm = mt[t] - mean; q += m2[t] + 256.0f * dm * dm; }
            S[row] = (f32x2v){mean, 1.0f / sqrtf(q / (256.0f * (float)ntn) + eps)};
        }
        asm volatile("s_waitcnt lgkmcnt(0)" ::: "memory"); __builtin_amdgcn_s_barrier(); asm volatile("" ::: "memory");
        return bad;
    }
};
struct EpiLnRes {
    static constexpr bool PERM = false, AFTER_DRAIN = true;
    const float* base; float* out; int ldc; const float* bias; PanelStats st; unsigned poison;
    __device__ __forceinline__ void fused(f32x4 (&acc)[2][2][4][2], const Unit& u, int wr, int wc, int fr, int fq, PG8_LAS unsigned char* lds, int wid, int lane) const {
        typedef float f32x2v __attribute__((ext_vector_type(2)));
        const PG8_LAS f32x2v* S = (const PG8_LAS f32x2v*)(lds + 8192);
        const int col0 = u.pn * BM + wc * 32 + 4 * fq;
#pragma unroll
        for (int bj = 0; bj < 2; ++bj)
#pragma unroll
            for (int n = 0; n < 2; ++n) { const f32x4 bv = bias ? *(const f32x4*)(bias + col0 + bj * HALF + n * 16) : (f32x4){0.f, 0.f, 0.f, 0.f};
#pragma unroll
                for (int ai = 0; ai < 2; ++ai)
#pragma unroll
                    for (int m = 0; m < 4; ++m) acc[ai][bj][m][n] += bv; }
        f32x4 pre[4][2][2];
#pragma unroll
        for (int m = 0; m < 4; ++m) { const size_t off = (size_t)(u.pm * BM + wr * 64 + m * 16 + fr) * ldc + col0;
#pragma unroll
            for (int bj = 0; bj < 2; ++bj)
#pragma unroll
                for (int n = 0; n < 2; ++n) pre[m][bj][n] = *(const f32x4*)(base + off + bj * HALF + n * 16); }
        const bool bad = st.run(acc, u, wr, wc, fr, fq, lds, wid, lane) || poison != 0u;
        const float qnan = __builtin_nanf("");
#pragma unroll
        for (int ai = 0; ai < 2; ++ai)
#pragma unroll
            for (int m = 0; m < 4; ++m) { const int r = ai * HALF + wr * 64 + m * 16 + fr; const f32x2v sr = S[r]; const size_t off = (size_t)(u.pm * BM + r) * ldc + col0;
#pragma unroll
                for (int bj = 0; bj < 2; ++bj)
#pragma unroll
                    for (int n = 0; n < 2; ++n) { const f32x4 bs = ai == 0 ? pre[m][bj][n] : *(const f32x4*)(base + off + bj * HALF + n * 16); f32x4 o = bs + (acc[ai][bj][m][n] - sr.x) * sr.y;
                        if (bad) o = (f32x4){qnan, qnan, qnan, qnan}; *(f32x4*)(out + off + bj * HALF + n * 16) = o; }
                if (m & 1) asm volatile("" ::: "memory"); }
    }
};
struct EpiLnResLn {
    static constexpr bool PERM = false, AFTER_DRAIN = true;
    const float* base; float* out; bf16_t* xn; int ldc; const float* bias; PanelStats st1, st2; unsigned poison;
    __device__ __forceinline__ void fused(f32x4 (&acc)[2][2][4][2], const Unit& u, int wr, int wc, int fr, int fq, PG8_LAS unsigned char* lds, int wid, int lane) const {
        typedef float f32x2v __attribute__((ext_vector_type(2))); typedef unsigned u32x2v __attribute__((ext_vector_type(2)));
        const PG8_LAS f32x2v* S = (const PG8_LAS f32x2v*)(lds + 8192);
        const int col0 = u.pn * BM + wc * 32 + 4 * fq;
#pragma unroll
        for (int bj = 0; bj < 2; ++bj)
#pragma unroll
            for (int n = 0; n < 2; ++n) { const f32x4 bv = bias ? *(const f32x4*)(bias + col0 + bj * HALF + n * 16) : (f32x4){0.f, 0.f, 0.f, 0.f};
#pragma unroll
                for (int ai = 0; ai < 2; ++ai)
#pragma unroll
                    for (int m = 0; m < 4; ++m) acc[ai][bj][m][n] += bv; }
        bool bad = st1.run(acc, u, wr, wc, fr, fq, lds, wid, lane) || poison != 0u;
        const float qnan = __builtin_nanf("");
#pragma unroll
        for (int ai = 0; ai < 2; ++ai)
#pragma unroll
            for (int m = 0; m < 4; ++m) { const int r = ai * HALF + wr * 64 + m * 16 + fr; const f32x2v sr = S[r]; const size_t off = (size_t)(u.pm * BM + r) * ldc + col0;
#pragma unroll
                for (int bj = 0; bj < 2; ++bj)
#pragma unroll
                    for (int n = 0; n < 2; ++n) { const f32x4 bs = *(const f32x4*)(base + off + bj * HALF + n * 16); acc[ai][bj][m][n] = bs + (acc[ai][bj][m][n] - sr.x) * sr.y; }
                asm volatile("" : "+v"(acc[ai][0][m][0]), "+v"(acc[ai][0][m][1]), "+v"(acc[ai][1][m][0]), "+v"(acc[ai][1][m][1]));
                if (m & 1) asm volatile("" ::: "memory"); }
        const bool bad1 = bad;
        bad = st2.run(acc, u, wr, wc, fr, fq, lds, wid, lane) || bad;
#pragma unroll
        for (int ai = 0; ai < 2; ++ai)
#pragma unroll
            for (int m = 0; m < 4; ++m) { const int r = ai * HALF + wr * 64 + m * 16 + fr; const f32x2v sr = S[r]; const size_t off = (size_t)(u.pm * BM + r) * ldc + col0;
#pragma unroll
                for (int bj = 0; bj < 2; ++bj)
#pragma unroll
                    for (int n = 0; n < 2; ++n) { const f32x4 x1 = acc[ai][bj][m][n]; *(f32x4*)(out + off + bj * HALF + n * 16) = bad1 ? (f32x4){qnan, qnan, qnan, qnan} : x1;
                        const f32x4 o = (x1 - sr.x) * sr.y; u32x2v w; w.x = cvt_pk_bf16(o[0], o[1]); w.y = cvt_pk_bf16(o[2], o[3]);
                        if (bad) { w.x = 0x7fc07fc0u; w.y = 0x7fc07fc0u; } *(u32x2v*)(xn + off + bj * HALF + n * 16) = w; }
                asm volatile("" ::: "memory"); }
    }
};

template <class Epi, class Sched, bool ALIGN_EPI = false, bool SP2 = false>
__device__ __forceinline__ void gemm_phase(PG8_LAS unsigned char* lds, const Gemm g, const Sched& S, const Epi& E) {
    int tid_ = threadIdx.x; asm volatile("" : "+v"(tid_));
    const int tid = tid_, wid = __builtin_amdgcn_readfirstlane(tid >> 6), lane = tid & 63, wr = wid >> 2, wc = wid & 3, fr = lane & 15, fq = lane >> 4;
    const int K = g.K, nt = K / BK;
    unsigned voffA[2], voffB[2];
#pragma unroll
    for (int i = 0; i < 2; ++i) { int R, C; stage_rc(tid * 16 + i * 8192, R, C); const int Rb = Epi::PERM ? ((R & ~31) + perm32(R & 31)) : R;
        voffA[i] = (unsigned)(R * K + C) * 2u; voffB[i] = (unsigned)(Rb * K + C) * 2u; }
    const size_t kstep = (size_t)(BK * 2);
    const size_t hstep = (size_t)HALF * K * 2;
    const size_t tstep = 2 * hstep;
    const unsigned ldsw = (unsigned)wid * 1024u;
    const int aoff = lds_byte(wr * 64 + fr, fq * 8), boff = lds_byte(wc * 32 + fr, fq * 8);
#define PG8_SA(b, h) (((b) * 2 + (h)) * HTB)
#define PG8_SB(b, h) ((4 + (b) * 2 + (h)) * HTB)
#define PG8_STAGE(bufoff, gbase, voff) do { _Pragma("unroll") for (int _i = 0; _i < 2; ++_i) \
        __builtin_amdgcn_global_load_lds((const unsigned*)((const char*)(gbase) + (voff)[_i]), (PG8_LAS unsigned*)(lds + (bufoff) + ldsw + _i * 8192), 16, 0, 0); } while (0)
#define PG8_LDA(dst, b, h) do { _Pragma("unroll") for (int m = 0; m < 4; ++m) _Pragma("unroll") for (int k = 0; k < 2; ++k) dst[m][k] = *(const PG8_LAS bf16x8*)(lds + PG8_SA(b, h) + aoff + m * 2048 + k * 1024); } while (0)
#define PG8_LDB(dst, b, h) do { _Pragma("unroll") for (int n = 0; n < 2; ++n) _Pragma("unroll") for (int k = 0; k < 2; ++k) dst[n][k] = *(const PG8_LAS bf16x8*)(lds + PG8_SB(b, h) + boff + n * 2048 + k * 1024); } while (0)
#define PG8_MMA(ai, bj, At, Bt) do { __builtin_amdgcn_s_setprio(1); _Pragma("unroll") for (int m = 0; m < 4; ++m) _Pragma("unroll") for (int n = 0; n < 2; ++n) _Pragma("unroll") for (int k = 0; k < 2; ++k) \
        acc[ai][bj][m][n] = __builtin_amdgcn_mfma_f32_16x16x32_bf16(Bt[n][k], At[m][k], acc[ai][bj][m][n], 0, 0, 0); __builtin_amdgcn_s_setprio(0); } while (0)
#define PG8_WAIT_V(n) asm volatile("s_waitcnt vmcnt(" #n ")" ::: "memory")
#define PG8_WAIT_L(n) asm volatile("s_waitcnt lgkmcnt(" #n ")" ::: "memory")
#define PG8_BAR __builtin_amdgcn_s_barrier()
#define PG8_SCHED __builtin_amdgcn_sched_barrier(0)
    Unit cur, nxt; int ui = 0;
    if (!S.next(0, cur)) return;
    f32x4 acc[2][2][4][2];
#pragma unroll
    for (int a = 0; a < 2; ++a)
#pragma unroll
        for (int b = 0; b < 2; ++b)
#pragma unroll
            for (int m = 0; m < 4; ++m)
#pragma unroll
                for (int n = 0; n < 2; ++n) acc[a][b][m][n] = (f32x4){0.f, 0.f, 0.f, 0.f};
    bf16x8 At[4][2], B0[2][2], B1[2][2];
    const char* cA = (const char*)g.A + (size_t)cur.pm * tstep; const char* cB = (const char*)g.Bt + (size_t)cur.pn * tstep;
    S.a_ready(cur);
    if constexpr (SP2) {
        PG8_STAGE(PG8_SB(0, 0), cB, voffB); PG8_STAGE(PG8_SB(0, 1), cB + hstep, voffB); PG8_STAGE(PG8_SA(0, 0), cA, voffA); PG8_STAGE(PG8_SA(0, 1), cA + hstep, voffA);
        if (wr == 1) PG8_BAR;
        PG8_WAIT_V(2); PG8_BAR;
        PG8_STAGE(PG8_SB(1, 0), cB + kstep, voffB); PG8_STAGE(PG8_SA(1, 0), cA + kstep, voffA); PG8_STAGE(PG8_SB(1, 1), cB + hstep + kstep, voffB);
        PG8_WAIT_V(6); PG8_BAR;
    } else {
        PG8_STAGE(PG8_SB(0, 0), cB, voffB); PG8_STAGE(PG8_SA(0, 0), cA, voffA); PG8_STAGE(PG8_SB(0, 1), cB + hstep, voffB); PG8_STAGE(PG8_SA(0, 1), cA + hstep, voffA);
        if (wr == 1) PG8_BAR;
        PG8_WAIT_V(4); PG8_BAR;
        PG8_STAGE(PG8_SB(1, 0), cB + kstep, voffB); PG8_STAGE(PG8_SA(1, 0), cA + kstep, voffA); PG8_STAGE(PG8_SB(1, 1), cB + hstep + kstep, voffB);
        PG8_WAIT_V(6); PG8_BAR;
    }
    for (;;) {
        const bool has_next = S.next(ui + 1, nxt);
        const char* nA = has_next ? (const char*)g.A + (size_t)nxt.pm * tstep : cA; const char* nB = has_next ? (const char*)g.Bt + (size_t)nxt.pn * tstep : cB;
        for (int t = 0; t < nt; t += 2) {
            const bool last = (t == nt - 2);
            const char* a1 = cA + (size_t)(t + 1) * kstep;
            const char* a2 = last ? nA : cA + (size_t)(t + 2) * kstep; const char* b2 = last ? nB : cB + (size_t)(t + 2) * kstep;
            const char* a3 = a2 + kstep; const char* b3 = b2 + kstep;
            if (last && has_next) S.a_ready(nxt);
            if constexpr (SP2) {
            PG8_LDB(B0, 0, 0); PG8_LDB(B1, 0, 1); PG8_SCHED; PG8_LDA(At, 0, 0); PG8_STAGE(PG8_SA(1, 1), a1 + hstep, voffA);
            PG8_WAIT_V(8); PG8_WAIT_L(0); PG8_BAR; PG8_MMA(0, 0, At, B0); PG8_MMA(0, 1, At, B1); PG8_BAR; PG8_SCHED;
            PG8_LDA(At, 0, 1); PG8_STAGE(PG8_SB(0, 0), b2, voffB); PG8_STAGE(PG8_SB(0, 1), b2 + hstep, voffB); PG8_STAGE(PG8_SA(0, 0), a2, voffA);
            PG8_WAIT_V(8); PG8_WAIT_L(0); PG8_BAR; PG8_MMA(1, 0, At, B0); PG8_MMA(1, 1, At, B1); PG8_BAR; PG8_SCHED;
            PG8_LDB(B0, 1, 0); PG8_LDB(B1, 1, 1); PG8_SCHED; PG8_LDA(At, 1, 0); PG8_STAGE(PG8_SA(0, 1), a2 + hstep, voffA);
            PG8_WAIT_V(8); PG8_WAIT_L(0); PG8_BAR; PG8_MMA(0, 0, At, B0); PG8_MMA(0, 1, At, B1); PG8_BAR; PG8_SCHED;
            PG8_LDA(At, 1, 1); PG8_STAGE(PG8_SB(1, 0), b3, voffB); PG8_STAGE(PG8_SB(1, 1), b3 + hstep, voffB); PG8_STAGE(PG8_SA(1, 0), a3, voffA);
            PG8_WAIT_V(8); PG8_WAIT_L(0); PG8_BAR; PG8_MMA(1, 0, At, B0); PG8_MMA(1, 1, At, B1); PG8_BAR; PG8_SCHED;
            } else {
            PG8_LDB(B0, 0, 0); PG8_SCHED; PG8_LDA(At, 0, 0); PG8_STAGE(PG8_SA(1, 1), a1 + hstep, voffA);
            PG8_WAIT_L(8); PG8_BAR; PG8_WAIT_L(0); PG8_MMA(0, 0, At, B0); PG8_BAR; PG8_SCHED;
            PG8_LDB(B1, 0, 1); PG8_STAGE(PG8_SB(0, 0), b2, voffB);
            PG8_BAR; PG8_WAIT_L(0); PG8_MMA(0, 1, At, B1); PG8_BAR;
            PG8_LDA(At, 0, 1); PG8_STAGE(PG8_SA(0, 0), a2, voffA);
            PG8_BAR; PG8_WAIT_L(0); PG8_MMA(1, 0, At, B0); PG8_BAR; PG8_SCHED;
            PG8_STAGE(PG8_SB(0, 1), b2 + hstep, voffB);
            PG8_WAIT_V(6); PG8_BAR; PG8_MMA(1, 1, At, B1); PG8_BAR;
            PG8_LDB(B0, 1, 0); PG8_SCHED; PG8_LDA(At, 1, 0); PG8_STAGE(PG8_SA(0, 1), a2 + hstep, voffA);
            PG8_WAIT_L(8); PG8_BAR; PG8_WAIT_L(0); PG8_MMA(0, 0, At, B0); PG8_BAR; PG8_SCHED;
            PG8_LDB(B1, 1, 1); PG8_STAGE(PG8_SB(1, 0), b3, voffB);
            PG8_BAR; PG8_WAIT_L(0); PG8_MMA(0, 1, At, B1); PG8_BAR;
            PG8_LDA(At, 1, 1); PG8_STAGE(PG8_SA(1, 0), a3, voffA);
            PG8_BAR; PG8_WAIT_L(0); PG8_MMA(1, 0, At, B0); PG8_BAR; PG8_SCHED;
            PG8_STAGE(PG8_SB(1, 1), b3 + hstep, voffB);
            PG8_WAIT_V(6); PG8_BAR; PG8_MMA(1, 1, At, B1); PG8_BAR;
            }
        }
        if constexpr (ALIGN_EPI) { if (wr == 0) PG8_BAR; }
        if constexpr (!Epi::AFTER_DRAIN) { E(acc, cur, wr, wc, fr, fq); S.done(cur); }
        if (!has_next) break;
#pragma unroll
        for (int a = 0; a < 2; ++a)
#pragma unroll
            for (int b = 0; b < 2; ++b)
#pragma unroll
                for (int m = 0; m < 4; ++m)
#pragma unroll
                    for (int n = 0; n < 2; ++n) acc[a][b][m][n] = (f32x4){0.f, 0.f, 0.f, 0.f};
        cur = nxt; cA = nA; cB = nB; ++ui;
        if constexpr (ALIGN_EPI) { if (wr == 1) PG8_BAR; }
    }
    PG8_WAIT_V(0);
    if constexpr (!ALIGN_EPI) { if (wr == 0) PG8_BAR; }
    PG8_BAR;
    if constexpr (Epi::AFTER_DRAIN) { E.fused(acc, cur, wr, wc, fr, fq, lds, wid, lane); S.done(cur); }
#undef PG8_SA
#undef PG8_SB
#undef PG8_STAGE
#undef PG8_LDA
#undef PG8_LDB
#undef PG8_MMA
#undef PG8_WAIT_V
#undef PG8_WAIT_L
#undef PG8_BAR
#undef PG8_SCHED
}
}
namespace attn {
using bf16 = __hip_bfloat16;
constexpr int   D = 128, NW = 8, QBLK = 32, KVBLK = 64;
constexpr float SCALE = 0.088388347648318440f;
constexpr float THR = 8.f;
constexpr int SDEPTH = 2;
constexpr int LDQ = 1024, LDK = 256, LDO = 1024;
constexpr size_t SHM_V = KVBLK * D * 2, SHM_K = KVBLK * D * 2, SHM_ATTN = 2 * SHM_V + 2 * SHM_K + NW * 64 * 4;
using bf16x8 = __attribute__((ext_vector_type(8))) short;
using s16x4  = __attribute__((ext_vector_type(4))) short;
using f32x16 = __attribute__((ext_vector_type(16))) float;
using f32x8  = __attribute__((ext_vector_type(8))) float;
using u32x4  = __attribute__((ext_vector_type(4))) unsigned;
#define KSWZ(row, colB) ((row) * 256 + ((colB) ^ (((row) & 7) << 4)))
#define SBAR() __builtin_amdgcn_sched_barrier(0)
__device__ __forceinline__ int crow(int r, int hi) { return (r & 3) + 8 * (r >> 2) + 4 * hi; }
__device__ __forceinline__ unsigned cvtpk(float lo, float hi) {
  unsigned r; asm volatile("v_cvt_pk_bf16_f32 %0, %1, %2" : "=v"(r) : "v"(lo), "v"(hi)); return r;
}
template <typename TIn> struct Stage;
template <> struct Stage<bf16>  { using T = bf16x8;
  __device__ static __forceinline__ T ld8(const bf16* p) { return *reinterpret_cast<const bf16x8*>(p); }
  __device__ static __forceinline__ bf16x8 tobf(T x) { return x; } };
template <> struct Stage<float> { using T = f32x8;
  __device__ static __forceinline__ T ld8(const float* p) { return *reinterpret_cast<const f32x8*>(p); }
  __device__ static __forceinline__ bf16x8 tobf(T x) {
    u32x4 w = {cvtpk(x[0], x[1]), cvtpk(x[2], x[3]), cvtpk(x[4], x[5]), cvtpk(x[6], x[7])}; return *reinterpret_cast<bf16x8*>(&w); } };

__device__ __forceinline__ void partialSM(f32x16& p0, f32x16& p1, float& m_reg, float& mn, float& alpha) {
  constexpr float C = SCALE * 1.4426950408889634f;
  float pmax = p0[0]; for (int r = 1; r < 16; ++r) pmax = fmaxf(pmax, p0[r]); for (int r = 0; r < 16; ++r) pmax = fmaxf(pmax, p1[r]);
  { auto rr = __builtin_amdgcn_permlane32_swap(__float_as_uint(pmax), __float_as_uint(pmax), false, false);
    pmax = fmaxf(__uint_as_float(rr[0]), __uint_as_float(rr[1])); }
  if (__builtin_expect(__all(pmax - m_reg <= THR / SCALE), 1)) { mn = m_reg; alpha = 1.f; }
  else { mn = fmaxf(m_reg, pmax); alpha = __builtin_amdgcn_exp2f((m_reg - mn) * C); m_reg = mn; }
  float mnC = -mn * C;
  for (int r = 0; r < 16; ++r) p0[r] = fmaf(p0[r], C, mnC); for (int r = 0; r < 16; ++r) p1[r] = fmaf(p1[r], C, mnC);
  for (int r = 0; r < 16; ++r) p0[r] = __builtin_amdgcn_exp2f(p0[r]);
}
__device__ __forceinline__ void finishSM(f32x16& p0, f32x16& p1, float alpha, float& l_reg, bf16x8& pa0, bf16x8& pa1, bf16x8& pa2, bf16x8& pa3) {
  for (int r = 0; r < 16; ++r) p1[r] = __builtin_amdgcn_exp2f(p1[r]);
  float ps = 0; for (int r = 0; r < 16; ++r) ps += p0[r]; for (int r = 0; r < 16; ++r) ps += p1[r];
  { auto rr = __builtin_amdgcn_permlane32_swap(__float_as_uint(ps), __float_as_uint(ps), false, false);
    ps = __uint_as_float(rr[0]) + __uint_as_float(rr[1]); }
  l_reg = l_reg * alpha + ps;
#define PK4(P, BASE, OUT) do { unsigned a0 = cvtpk(P[BASE + 0], P[BASE + 1]), a1 = cvtpk(P[BASE + 2], P[BASE + 3]);   \
    unsigned b0 = cvtpk(P[BASE + 4], P[BASE + 5]), b1 = cvtpk(P[BASE + 6], P[BASE + 7]);                              \
    auto r0 = __builtin_amdgcn_permlane32_swap(a0, b0, false, false); auto r1 = __builtin_amdgcn_permlane32_swap(a1, b1, false, false); \
    u32x4 w = {r0[0], r1[0], r0[1], r1[1]}; OUT = *reinterpret_cast<bf16x8*>(&w); } while (0)
  PK4(p0, 0, pa0); PK4(p0, 8, pa1); PK4(p1, 0, pa2); PK4(p1, 8, pa3);
#undef PK4
}
__device__ __forceinline__ void qkt(f32x16& p0, f32x16& p1, const bf16* Ks, const bf16x8* qr, int r32, int hi) {
  p0 = f32x16{}; p1 = f32x16{};
  for (int d0 = 0; d0 < 8; ++d0) { int cb = (d0 * 16 + hi * 8) * 2;
    bf16x8 b0 = *reinterpret_cast<const bf16x8*>((const char*)Ks + KSWZ(r32, cb));
    bf16x8 b1 = *reinterpret_cast<const bf16x8*>((const char*)Ks + KSWZ(32 + r32, cb));
    p0 = __builtin_amdgcn_mfma_f32_32x32x16_bf16(b0, qr[d0], p0, 0, 0, 0);
    p1 = __builtin_amdgcn_mfma_f32_32x32x16_bf16(b1, qr[d0], p1, 0, 0, 0); }
}
__device__ __forceinline__ int v_st(int k, int c) { const int kk = (k & ~0xC) | ((k & 4) << 1) | ((k & 8) >> 1); return ((kk >> 3) * 4 + (c >> 5)) * 512 + ((kk & 7) * 32 + (c & 31)) * 2; }
__device__ __forceinline__ int v_rd_base(int lane) { return ((lane & 3) << 3) | (((lane >> 2) & 3) << 6) | (((lane >> 4) & 1) << 5) | (((lane >> 5) & 1) << 8); }
constexpr int v_rd_off(int d0, int ks, int half) { return d0 * 512 + ks * 4096 + half * 2048; }
template <int OFF> __device__ __forceinline__ s16x4 tr_read(int vb) {
  s16x4 r; asm volatile("ds_read_b64_tr_b16 %0, %1 offset:%2" : "=&v"(r) : "v"(vb), "i"(OFF) : "memory"); return r;
}
template <int D0> __device__ __forceinline__ void pv_one(f32x16& od, int vb, bf16x8 pa0, bf16x8 pa1, bf16x8 pa2, bf16x8 pa3) {
  const s16x4 l0 = tr_read<v_rd_off(D0, 0, 0)>(vb), h0 = tr_read<v_rd_off(D0, 0, 1)>(vb), l1 = tr_read<v_rd_off(D0, 1, 0)>(vb), h1 = tr_read<v_rd_off(D0, 1, 1)>(vb);
  const s16x4 l2 = tr_read<v_rd_off(D0, 2, 0)>(vb), h2 = tr_read<v_rd_off(D0, 2, 1)>(vb), l3 = tr_read<v_rd_off(D0, 3, 0)>(vb), h3 = tr_read<v_rd_off(D0, 3, 1)>(vb);
  asm volatile("s_waitcnt lgkmcnt(0)" ::: "memory"); SBAR();
#define PK(L, H) (bf16x8){L[0], L[1], L[2], L[3], H[0], H[1], H[2], H[3]}
  od = __builtin_amdgcn_mfma_f32_32x32x16_bf16(pa0, PK(l0, h0), od, 0, 0, 0);
  od = __builtin_amdgcn_mfma_f32_32x32x16_bf16(pa1, PK(l1, h1), od, 0, 0, 0);
  od = __builtin_amdgcn_mfma_f32_32x32x16_bf16(pa2, PK(l2, h2), od, 0, 0, 0);
  od = __builtin_amdgcn_mfma_f32_32x32x16_bf16(pa3, PK(l3, h3), od, 0, 0, 0);
#undef PK
}
__device__ __forceinline__ void pv_d0(f32x16* o, int vb, bf16x8 pa0, bf16x8 pa1, bf16x8 pa2, bf16x8 pa3) {
  pv_one<0>(o[0], vb, pa0, pa1, pa2, pa3); pv_one<1>(o[1], vb, pa0, pa1, pa2, pa3); pv_one<2>(o[2], vb, pa0, pa1, pa2, pa3); pv_one<3>(o[3], vb, pa0, pa1, pa2, pa3);
}

template <typename TQ>
__device__ __forceinline__ void attn_dense_body(const TQ* __restrict__ Qb, const bf16* __restrict__ Kh, const bf16* __restrict__ Vh,
                                                unsigned short* Ob, int seq, char* lds) {
  using St = Stage<bf16>; using SQ = Stage<TQ>;
  int tid_ = threadIdx.x; asm volatile("" : "+v"(tid_));
  const int tid = tid_, wid = tid >> 6, lane = tid & 63, r32 = lane & 31, hi = lane >> 5;
  bf16* V_lds = (bf16*)lds; bf16* K_lds = (bf16*)(lds + 2 * SHM_V);
  float* ws = (float*)(lds + 2 * SHM_V + 2 * SHM_K) + wid * 64; float* li_l = ws; float* al_l = ws + 32;
  float m_reg = -1e30f, l_reg = 0; f32x16 o[4] = {}; bf16x8 qr[8];
  const TQ* Qw = Qb + (long)(wid * QBLK + r32) * LDQ + hi * 8;
#pragma unroll
  for (int d0 = 0; d0 < 8; ++d0) qr[d0] = SQ::tobf(SQ::ld8(Qw + d0 * 16));
  const int sr = tid >> 4, sc = (tid & 15) * 8, vst0 = v_st(sr, sc), vst1 = v_st(32 + sr, sc);
  const int vb0 = (int)(uintptr_t)V_lds + v_rd_base(lane);
  struct { typename St::T vs0, vs1, ks0, ks1; } sr_[SDEPTH];
#define SLOAD(i, k0) do { sr_[i].vs0 = St::ld8(&Vh[(long)((k0) + sr) * LDK + sc]); sr_[i].vs1 = St::ld8(&Vh[(long)((k0) + 32 + sr) * LDK + sc]); \
    sr_[i].ks0 = St::ld8(&Kh[(long)((k0) + sr) * LDK + sc]); sr_[i].ks1 = St::ld8(&Kh[(long)((k0) + 32 + sr) * LDK + sc]); } while (0)
#define SWRITE(b, i) do { *(bf16x8*)((char*)V_lds + (b) * SHM_V + vst0) = St::tobf(sr_[i].vs0);          \
    *(bf16x8*)((char*)V_lds + (b) * SHM_V + vst1) = St::tobf(sr_[i].vs1); int kc = sc * 2;               \
    *(bf16x8*)((char*)K_lds + (b) * SHM_K + KSWZ(sr, kc)) = St::tobf(sr_[i].ks0);                       \
    *(bf16x8*)((char*)K_lds + (b) * SHM_K + KSWZ(32 + sr, kc)) = St::tobf(sr_[i].ks1); } while (0)
#define SWAIT() do { if constexpr (SDEPTH == 2) asm volatile("s_waitcnt vmcnt(4)" ::: "memory"); else asm volatile("s_waitcnt vmcnt(0)" ::: "memory"); } while (0)
#define RESC(a) do { if (__any((a) < 1.f)) { if (hi == 0) al_l[r32] = (a); asm volatile("s_waitcnt lgkmcnt(0)" ::: "memory"); \
    for (int d = 0; d < 4; ++d) for (int r = 0; r < 16; ++r) o[d][r] *= al_l[crow(r, hi)]; } } while (0)
  f32x16 pA0, pA1, pB0, pB1; float mnA, mnB, alA, alB; bf16x8 pa0, pa1, pa2, pa3; const int NT = seq / KVBLK;
  constexpr int SE = 0, SO = SDEPTH - 1;
  SLOAD(SE, 0); asm volatile("s_waitcnt vmcnt(0)" ::: "memory"); SWRITE(0, SE); __syncthreads();
  qkt(pA0, pA1, K_lds, qr, r32, hi); partialSM(pA0, pA1, m_reg, mnA, alA);
  SLOAD(SO, KVBLK); if constexpr (SDEPTH == 2) { if (2 < NT) SLOAD(SE, 2 * KVBLK); }
  SWAIT(); SWRITE(1, SO); __syncthreads();
  for (int j = 1; j + 1 < NT; j += 2) {
    SBAR(); qkt(pB0, pB1, (bf16*)((char*)K_lds + SHM_K), qr, r32, hi);
    finishSM(pA0, pA1, alA, l_reg, pa0, pa1, pa2, pa3); SBAR();
    SLOAD(SO, (j + SDEPTH) * KVBLK); SBAR();
    pv_d0(o, vb0, pa0, pa1, pa2, pa3); partialSM(pB0, pB1, m_reg, mnB, alB);
    __syncthreads(); SWAIT(); SWRITE(0, SE);
    RESC(alB); __syncthreads();
    SBAR(); qkt(pA0, pA1, K_lds, qr, r32, hi);
    finishSM(pB0, pB1, alB, l_reg, pa0, pa1, pa2, pa3); SBAR();
    if (SDEPTH == 1 || j + 3 < NT) SLOAD(SE, (j + 1 + SDEPTH) * KVBLK); SBAR();
    pv_d0(o, vb0 + (int)SHM_V, pa0, pa1, pa2, pa3); partialSM(pA0, pA1, m_reg, mnA, alA);
    __syncthreads(); SWAIT(); SWRITE(1, SO);
    RESC(alA); __syncthreads();
  }
  SBAR(); qkt(pB0, pB1, (bf16*)((char*)K_lds + SHM_K), qr, r32, hi);
  finishSM(pA0, pA1, alA, l_reg, pa0, pa1, pa2, pa3); SBAR();
  pv_d0(o, vb0, pa0, pa1, pa2, pa3); partialSM(pB0, pB1, m_reg, mnB, alB);
  __syncthreads(); RESC(alB);
  finishSM(pB0, pB1, alB, l_reg, pa0, pa1, pa2, pa3); SBAR();
  pv_d0(o, vb0 + (int)SHM_V, pa0, pa1, pa2, pa3);
  if (hi == 0) li_l[r32] = l_reg; asm volatile("s_waitcnt lgkmcnt(0)" ::: "memory");
  float rli[16];
#pragma unroll
  for (int r = 0; r < 16; ++r) rli[r] = __builtin_amdgcn_rcpf(li_l[crow(r, hi)]);
  unsigned short* Ow = Ob + (long)(wid * QBLK) * LDO;
#pragma unroll
  for (int r = 0; r < 16; ++r) { int orow = crow(r, hi);
    for (int d0 = 0; d0 < 4; ++d0) Ow[(long)orow * LDO + d0 * 32 + r32] = (unsigned short)(cvtpk(o[d0][r] * rli[r], 0.f) & 0xffffu); }
#undef SLOAD
#undef SWRITE
#undef SWAIT
#undef RESC
}
#undef KSWZ
#undef SBAR
}
#define GAS __attribute__((address_space(1)))
#define LAS __attribute__((address_space(3)))
typedef unsigned short bf16_t;
typedef unsigned v4u __attribute__((ext_vector_type(4)));
typedef unsigned v2u __attribute__((ext_vector_type(2)));
typedef float f32x4 __attribute__((ext_vector_type(4)));
typedef float f32x16 __attribute__((ext_vector_type(16)));
typedef short bf16x8 __attribute__((ext_vector_type(8)));
typedef short bf16x4 __attribute__((ext_vector_type(4)));

constexpr int DM = 1024, NB = 32, SEQ = 2048, CTXL = 256;
constexpr int ML = NB * SEQ, MC = NB * CTXL, MT = ML + MC;
constexpr int DFF = 2816, NFF1 = 2 * DFF;
constexpr int NMODC = 9 * DM;
constexpr int KVS = SEQ + CTXL;
constexpr int NQKV = 1536, NMLIN = 3088, NMLPAD = 3328, PLD = 3072;
constexpr float ALPHA = 1.41421356237309515f;
constexpr float LN_EPS = 1e-5f, RMS_EPS = 1e-6f;
constexpr int NWAVES = 8, NTHR = 512;
constexpr int LDS_BYTES = 132096;

constexpr size_t MiB = 1u << 20;
constexpr size_t WS_W1 = 4 * MiB;
constexpr size_t W1_SZ = (size_t)NFF1 * DM * 2;
constexpr size_t WS_W2 = WS_W1 + 4 * W1_SZ;
constexpr size_t W2_SZ = (size_t)DM * DFF * 2;
constexpr size_t WS_WQKV = WS_W2 + 4 * W2_SZ;
constexpr size_t WS_WOA = WS_WQKV + (size_t)NQKV * DM * 2;
constexpr size_t WS_WMI = WS_WOA + (size_t)DM * DM * 2;
constexpr size_t WS_WMO = WS_WMI + (size_t)NMLPAD * DM * 2;
constexpr size_t WS_WEND = WS_WMO + (size_t)DM * DM * 2;
static_assert(WS_WEND <= 92 * MiB, "weights");
constexpr size_t WS_MOD = 92 * MiB;
constexpr size_t WS_ROPE = 95 * MiB;
constexpr size_t WS_H = 96 * MiB;
constexpr size_t WS_XM = 384 * MiB;
constexpr size_t WS_BIG = 528 * MiB;
constexpr size_t WS_Q = WS_BIG, WS_K = WS_BIG + 144 * MiB, WS_V = WS_K + 36 * MiB;
constexpr size_t WS_G = 960 * MiB;
constexpr size_t WS_END = 966 * MiB;

using attn::cvtpk;
__device__ __forceinline__ float bflo(unsigned w) { return __uint_as_float(w << 16); }
__device__ __forceinline__ float bfhi(unsigned w) { return __uint_as_float(w & 0xffff0000u); }
__device__ __forceinline__ float siluf(float a) { return a * __builtin_amdgcn_rcpf(1.f + __expf(-a)); }
__device__ __forceinline__ float wave_sum(float v) {
#pragma unroll
    for (int o = 1; o < 64; o <<= 1) v += __shfl_xor(v, o);
    return v;
}
#define LDS_WAIT() asm volatile("s_waitcnt lgkmcnt(0)" ::: "memory")

struct EpiSwiglu {
    static constexpr bool PERM = true, AFTER_DRAIN = false;
    bf16_t* O;
    __device__ __forceinline__ void operator()(const pg8::f32x4 (&acc)[2][2][4][2], const pg8::Unit& u, int wr, int wc, int fr, int fq) const {
        const int row0 = u.pm * 256 + wr * 64 + fr, col0 = u.pn * 128 + wc * 32 + 8 * fq;
#pragma unroll
        for (int ai = 0; ai < 2; ++ai)
#pragma unroll
            for (int m = 0; m < 4; ++m) {
                bf16_t* rowp = O + (size_t)(row0 + ai * 128 + m * 16) * DFF + col0;
                const pg8::f32x4 a0 = acc[ai][0][m][0], a1 = acc[ai][0][m][1], u0 = acc[ai][1][m][0], u1 = acc[ai][1][m][1];
                v4u w;
                w.x = cvtpk(siluf(a0[0]) * u0[0], siluf(a0[1]) * u0[1]); w.y = cvtpk(siluf(a0[2]) * u0[2], siluf(a0[3]) * u0[3]);
                w.z = cvtpk(siluf(a1[0]) * u1[0], siluf(a1[1]) * u1[1]); w.w = cvtpk(siluf(a1[2]) * u1[2], siluf(a1[3]) * u1[3]);
                *(v4u*)rowp = w;
            }
    }
};
struct EpiResid {
    static constexpr bool PERM = false, AFTER_DRAIN = false;
    const float* res_lat; const float* res_ctx; float* Hout; const float* gate; float gs;
    __device__ __forceinline__ void operator()(const pg8::f32x4 (&acc)[2][2][4][2], const pg8::Unit& u, int wr, int wc, int fr, int fq) const {
        const int r0 = u.pm * 256, row0 = r0 + wr * 64 + fr, col0 = u.pn * 256 + wc * 32 + 4 * fq;
        const int bi = r0 < ML ? (r0 >> 11) : NB;
        pg8::f32x4 gv[2][2];
#pragma unroll
        for (int bj = 0; bj < 2; ++bj)
#pragma unroll
            for (int n = 0; n < 2; ++n) gv[bj][n] = *(const pg8::f32x4*)(gate + (size_t)bi * NMODC + col0 + bj * 128 + n * 16) * gs;
#pragma unroll
        for (int ai = 0; ai < 2; ++ai)
#pragma unroll
            for (int m = 0; m < 4; ++m) {
                const int row = row0 + ai * 128 + m * 16;
                const float* rp = (row < ML ? res_lat + (size_t)row * DM : res_ctx + (size_t)(row - ML) * DM) + col0;
                float* op = Hout + (size_t)row * DM + col0;
#pragma unroll
                for (int bj = 0; bj < 2; ++bj)
#pragma unroll
                    for (int n = 0; n < 2; ++n) {
                        const pg8::f32x4 r4 = *(const pg8::f32x4*)(rp + bj * 128 + n * 16);
                        *(pg8::f32x4*)(op + bj * 128 + n * 16) = r4 * ALPHA + gv[bj][n] * acc[ai][bj][m][n];
                    }
                asm volatile("" ::: "memory");
            }
    }
};
struct EpiQKV {
    static constexpr bool PERM = true, AFTER_DRAIN = false;
    bf16_t* Q; bf16_t* Kb; bf16_t* Vb;
    __device__ __forceinline__ void operator()(const pg8::f32x4 (&acc)[2][2][4][2], const pg8::Unit& u, int wr, int wc, int fr, int fq) const {
        const int r0 = u.pm * 256; bf16_t* base; int ld;
        if (u.pn < 4) { base = Q + (size_t)r0 * DM + u.pn * 256; ld = DM; }
        else { const int kvr = r0 < ML ? (r0 >> 11) * KVS + (r0 & 2047) : ((r0 - ML) >> 8) * KVS + SEQ + ((r0 - ML) & 255);
               base = (u.pn == 4 ? Kb : Vb) + (size_t)kvr * 256; ld = 256; }
        const int rl = wr * 64 + fr, col0 = wc * 32 + 8 * fq;
#pragma unroll
        for (int ai = 0; ai < 2; ++ai)
#pragma unroll
            for (int m = 0; m < 4; ++m) {
                bf16_t* rowp = base + (size_t)(rl + ai * 128 + m * 16) * ld + col0;
#pragma unroll
                for (int bj = 0; bj < 2; ++bj) { const pg8::f32x4 v0 = acc[ai][bj][m][0], v1 = acc[ai][bj][m][1];
                    v4u w; w.x = cvtpk(v0[0], v0[1]); w.y = cvtpk(v0[2], v0[3]); w.z = cvtpk(v1[0], v1[1]); w.w = cvtpk(v1[2], v1[3]);
                    *(v4u*)(rowp + bj * 128) = w; }
            }
    }
};
struct EpiMlIn {
    static constexpr bool PERM = true, AFTER_DRAIN = false;
    bf16_t* P; float* G; const float* gate_b;
    __device__ __forceinline__ void operator()(const pg8::f32x4 (&acc)[2][2][4][2], const pg8::Unit& u, int wr, int wc, int fr, int fq) const {
        const int row0 = u.pm * 256 + wr * 64 + fr;
        if (u.pn < 12) {
            const int col0 = u.pn * 256 + wc * 32 + 8 * fq;
#pragma unroll
            for (int ai = 0; ai < 2; ++ai)
#pragma unroll
                for (int m = 0; m < 4; ++m) {
                    bf16_t* rowp = P + (size_t)(row0 + ai * 128 + m * 16) * PLD + col0;
#pragma unroll
                    for (int bj = 0; bj < 2; ++bj) { const pg8::f32x4 v0 = acc[ai][bj][m][0], v1 = acc[ai][bj][m][1];
                        v4u w; w.x = cvtpk(v0[0], v0[1]); w.y = cvtpk(v0[2], v0[3]); w.z = cvtpk(v1[0], v1[1]); w.w = cvtpk(v1[2], v1[3]);
                        *(v4u*)(rowp + bj * 128) = w; }
                }
        } else if (wc == 0 && fq < 2) {
            const pg8::f32x4 b0 = *(const pg8::f32x4*)(gate_b + 8 * fq), b1 = *(const pg8::f32x4*)(gate_b + 8 * fq + 4);
#pragma unroll
            for (int ai = 0; ai < 2; ++ai)
#pragma unroll
                for (int m = 0; m < 4; ++m) {
                    float* gp = G + (size_t)(row0 + ai * 128 + m * 16) * 16 + 8 * fq;
                    *(pg8::f32x4*)gp = acc[ai][0][m][0] + b0; *(pg8::f32x4*)(gp + 4) = acc[ai][0][m][1] + b1;
                }
        }
    }
};
struct Args { const float* in[20]; float* out; unsigned char* ws; int ph_lo, ph_hi; };
struct Ctx {
    LAS unsigned char* lds; char* ldsg;
    int tid, lane, wave, G, bid;
    float* out; unsigned char* ws;
};
__device__ __forceinline__ unsigned long long karg_u64(int byte_off) {
    unsigned long long base = (unsigned long long)__builtin_amdgcn_kernarg_segment_ptr(); asm volatile("" : "+s"(base));
    return *(const __attribute__((address_space(4))) unsigned long long*)(base + byte_off);
}
#define ARG_IN(i) ((const float*)karg_u64(8 * (i)))
__device__ __forceinline__ void relane(Ctx& F) {
    int t_ = threadIdx.x; asm volatile("" : "+v"(t_)); F.tid = t_; F.lane = t_ & 63; F.wave = __builtin_amdgcn_readfirstlane(t_ >> 6);
    int b_ = blockIdx.x, g_ = gridDim.x; asm volatile("" : "+s"(b_), "+s"(g_)); F.bid = b_; F.G = g_;
    F.out = (float*)karg_u64(160); F.ws = (unsigned char*)karg_u64(168);
}
__device__ __forceinline__ void transpose_item(const float* __restrict__ W, int K, int N, bf16_t* WT, int k0, int n0, int drow0, LAS float* scr, int lane) {
    const int nn = n0 + (lane & 31); const bool ok = nn < N;
#pragma unroll 8
    for (int i = 0; i < 32; ++i) { const int kk = 2 * i + (lane >> 5); scr[kk * 33 + (lane & 31)] = ok ? W[(size_t)(k0 + kk) * N + nn] : 0.f; }
    LDS_WAIT(); asm volatile("" ::: "memory");
    const int c = lane & 7;
#pragma unroll
    for (int j = 0; j < 4; ++j) { const int n = (lane >> 3) + 8 * j; const LAS float* s = scr + (8 * c) * 33 + n;
        v4u o; o.x = cvtpk(s[0 * 33], s[1 * 33]); o.y = cvtpk(s[2 * 33], s[3 * 33]); o.z = cvtpk(s[4 * 33], s[5 * 33]); o.w = cvtpk(s[6 * 33], s[7 * 33]);
        *(v4u*)(WT + (size_t)(drow0 + n) * K + k0 + 8 * c) = o; }
    LDS_WAIT(); asm volatile("" ::: "memory");
}
__device__ __forceinline__ void p0_weights(Ctx& F, const float* w_ffn_in, const float* w_ffn_out, const float* w_att_in, const float* w_att_out, const float* w_ml_in, const float* w_ml_out) {
    LAS float* scr = (LAS float*)(F.lds + F.wave * 8448);
    const int gw = F.bid * NWAVES + F.wave, NGW = F.G * NWAVES;
    constexpr int I_W1 = 16 * (NFF1 / 32), I_W2 = (DFF / 64) * (DM / 32), I_QKV = 16 * (NQKV / 32), I_O = 16 * 32, I_MI = 16 * (NMLPAD / 32);
    constexpr int NITEMS = 4 * I_W1 + 4 * I_W2 + I_QKV + I_O + I_MI + I_O;
    for (int it = gw; it < NITEMS; it += NGW) {
        int r = it; const float* src; bf16_t* dst; int K, N, nblk, mode = 0;
        if (r < 4 * I_W1) { const int mi = r / I_W1; r -= mi * I_W1; src = w_ffn_in + (size_t)mi * DM * NFF1; dst = (bf16_t*)(F.ws + WS_W1 + mi * W1_SZ); K = DM; N = NFF1; nblk = NFF1 / 32; mode = 1; }
        else if ((r -= 4 * I_W1) < 4 * I_W2) { const int mi = r / I_W2; r -= mi * I_W2; src = w_ffn_out + (size_t)mi * DFF * DM; dst = (bf16_t*)(F.ws + WS_W2 + mi * W2_SZ); K = DFF; N = DM; nblk = DM / 32; }
        else if ((r -= 4 * I_W2) < I_QKV) { src = w_att_in; dst = (bf16_t*)(F.ws + WS_WQKV); K = DM; N = NQKV; nblk = NQKV / 32; }
        else if ((r -= I_QKV) < I_O) { src = w_att_out; dst = (bf16_t*)(F.ws + WS_WOA); K = DM; N = DM; nblk = DM / 32; }
        else if ((r -= I_O) < I_MI) { src = w_ml_in; dst = (bf16_t*)(F.ws + WS_WMI); K = DM; N = NMLIN; nblk = NMLPAD / 32; }
        else { r -= I_MI; src = w_ml_out; dst = (bf16_t*)(F.ws + WS_WMO); K = DM; N = DM; nblk = DM / 32; }
        const int kb = r / nblk, nb = r - kb * nblk, n0 = 32 * nb;
        int drow = n0;
        if (mode == 1) { const int j0 = n0 < DFF ? n0 : n0 - DFF; drow = 256 * (j0 >> 7) + (j0 & 127) + (n0 < DFF ? 0 : 128); }
        transpose_item(src, K, N, dst, 64 * kb, n0, drow, scr, F.lane);
    }
}
__device__ __forceinline__ void p0_mods(Ctx& F, const float* c, const float* cctx, const float* ada_w, const float* ada_b) {
    float* MOD = (float*)(F.ws + WS_MOD);
    LAS float* sv = (LAS float*)(F.lds + 0) + F.wave * (33 * 32);
    LAS float* red = (LAS float*)(F.lds + 8 * 33 * 32 * 4);
    for (int task = F.bid; task < 2 * (NMODC / 64); task += F.G) {
        const int l = task / (NMODC / 64), n0 = (task % (NMODC / 64)) * 64;
        const float* Wl = ada_w + (size_t)l * DM * NMODC + n0 + F.lane;
        float acc[33];
#pragma unroll
        for (int b = 0; b < 33; ++b) acc[b] = 0.f;
        for (int sub = 0; sub < 4; ++sub) {
            const int k0 = F.wave * 128 + sub * 32;
            for (int idx = F.lane; idx < 33 * 32; idx += 64) { const int b = idx >> 5, kk = idx & 31; const float cv = b < 32 ? c[b * DM + k0 + kk] : cctx[k0 + kk];
                sv[idx] = cv / (1.f + expf(-cv)); }
            LDS_WAIT(); asm volatile("" ::: "memory");
            for (int k4 = 0; k4 < 8; ++k4) {
                const float w0 = Wl[(size_t)(k0 + 4 * k4 + 0) * NMODC], w1 = Wl[(size_t)(k0 + 4 * k4 + 1) * NMODC], w2 = Wl[(size_t)(k0 + 4 * k4 + 2) * NMODC], w3 = Wl[(size_t)(k0 + 4 * k4 + 3) * NMODC];
#pragma unroll
                for (int b = 0; b < 33; ++b) { const f32x4 s4 = *(const LAS f32x4*)(sv + b * 32 + 4 * k4); acc[b] += s4[0] * w0 + s4[1] * w1 + s4[2] * w2 + s4[3] * w3; }
            }
            LDS_WAIT(); asm volatile("" ::: "memory");
        }
#pragma unroll
        for (int b = 0; b < 33; ++b) red[(F.wave * 33 + b) * 64 + F.lane] = acc[b];
        __syncthreads();
        for (int o = F.tid; o < 33 * 64; o += NTHR) { const int b = o >> 6, n = o & 63; float s = ada_b[l * NMODC + n0 + n];
#pragma unroll
            for (int w = 0; w < 8; ++w) s += red[(w * 33 + b) * 64 + n];
            MOD[((size_t)l * 33 + b) * NMODC + n0 + n] = s; }
        __syncthreads();
    }
}
__device__ __forceinline__ void p0_rope(Ctx& F) {
    float* CS = (float*)(F.ws + WS_ROPE); float* SN = CS + SEQ * 64;
    for (int i = F.bid * NTHR + F.tid; i < SEQ * 64; i += F.G * NTHR) {
        const int t = i >> 6, ax = (i >> 5) & 1, p = i & 31;
        const float pos = (float)(ax == 0 ? (t >> 6) : (t & 63));
        const float inv = powf(10000.0f, -(float)p / 32.0f);
        const float ang = pos * inv;
        CS[i] = cosf(ang); SN[i] = sinf(ang);
    }
}
template <int MODE>
__device__ __forceinline__ void row_pass(Ctx& F, const float* xin, const float* ctxin, int M, const float* g, const float* bta, const float* MODl, int shift_idx, int scale_idx) {
    float* H = (float*)(F.ws + WS_H); bf16_t* XM = (bf16_t*)(F.ws + WS_XM);
    const int gw = F.bid * NWAVES + F.wave, NGW = F.G * NWAVES;
    for (int row = gw; row < M; row += NGW) {
        const float* src = MODE == 0 ? (row < ML ? xin + (size_t)row * DM : ctxin + (size_t)(row - ML) * DM) : H + (size_t)row * DM;
        const f32x4* xr = (const f32x4*)src + F.lane;
        f32x4 v[4];
#pragma unroll
        for (int j = 0; j < 4; ++j) v[j] = xr[64 * j];
        if (MODE != 0) {
            float s = 0.f;
#pragma unroll
            for (int j = 0; j < 4; ++j) s += (v[j][0] + v[j][1]) + (v[j][2] + v[j][3]);
            const float mean = wave_sum(s) * (1.f / DM); float s2 = 0.f;
#pragma unroll
            for (int j = 0; j < 4; ++j) { v[j] = v[j] - mean; s2 += (v[j][0] * v[j][0] + v[j][1] * v[j][1]) + (v[j][2] * v[j][2] + v[j][3] * v[j][3]); }
            const float rstd = 1.f / sqrtf(wave_sum(s2) * (1.f / DM) + LN_EPS);
#pragma unroll
            for (int j = 0; j < 4; ++j) { const int col = 4 * F.lane + 256 * j; const f32x4 gv = *(const f32x4*)(g + col), bv = *(const f32x4*)(bta + col); v[j] = v[j] * rstd * gv + bv; }
        }
        if (MODE == 2) {
            f32x4* o = (f32x4*)(F.out + (size_t)row * DM) + F.lane;
#pragma unroll
            for (int j = 0; j < 4; ++j) o[64 * j] = v[j];
        } else {
            if (MODE == 1) { f32x4* o = (f32x4*)(H + (size_t)row * DM) + F.lane;
#pragma unroll
                for (int j = 0; j < 4; ++j) o[64 * j] = v[j]; }
            const int bi = row < ML ? (row >> 11) : NB;
            const float* mb = MODl + (size_t)bi * NMODC;
            v2u* xo = (v2u*)(XM + (size_t)row * DM) + F.lane;
#pragma unroll
            for (int j = 0; j < 4; ++j) { const int col = 4 * F.lane + 256 * j;
                const f32x4 sh = *(const f32x4*)(mb + shift_idx * DM + col), sc = *(const f32x4*)(mb + scale_idx * DM + col);
                const f32x4 y = v[j] * (sc + 1.f) + sh;
                v2u w; w.x = cvtpk(y[0], y[1]); w.y = cvtpk(y[2], y[3]); xo[64 * j] = w; }
        }
    }
}
__device__ __forceinline__ void qknorm_rope(Ctx& F, const float* qg, const float* kg) {
    bf16_t* Q = (bf16_t*)(F.ws + WS_Q); bf16_t* Kb = (bf16_t*)(F.ws + WS_K);
    const float* CS = (const float*)(F.ws + WS_ROPE); const float* SN = CS + SEQ * 64;
    const int gw = F.bid * NWAVES + F.wave, NGW = F.G * NWAVES;
    const int grp = F.lane >> 4, j = F.lane & 15, half = (j >> 2) & 1;
    float gq[8], gk[8];
#pragma unroll
    for (int e = 0; e < 8; ++e) { gq[e] = qg[8 * j + e]; gk[e] = kg[8 * j + e]; }
    for (int it = gw; it < MT / 4; it += NGW) {
        const int row = it * 4 + grp; const bool lat = row < ML;
        const int kvr = lat ? (row >> 11) * KVS + (row & 2047) : ((row - ML) >> 8) * KVS + SEQ + ((row - ML) & 255);
        float cs[8], sn[8];
        if (lat) { const int t = row & 2047; const float* cp = CS + t * 64 + (j >> 3) * 32 + (j & 3) * 8; const float* sp = SN + t * 64 + (j >> 3) * 32 + (j & 3) * 8;
#pragma unroll
            for (int e = 0; e < 8; ++e) { cs[e] = cp[e]; sn[e] = half ? sp[e] : -sp[e]; } }
        else {
#pragma unroll
            for (int e = 0; e < 8; ++e) { cs[e] = 1.f; sn[e] = 0.f; } }
#pragma unroll 2
        for (int hh = 0; hh < 10; ++hh) {
            bf16_t* p = hh < 8 ? Q + (size_t)row * DM + hh * 128 + 8 * j : Kb + (size_t)kvr * 256 + (hh - 8) * 128 + 8 * j;
            const v4u w = *(const v4u*)p;
            float x[8] = {bflo(w.x), bfhi(w.x), bflo(w.y), bfhi(w.y), bflo(w.z), bfhi(w.z), bflo(w.w), bfhi(w.w)};
            float ss = 0.f;
#pragma unroll
            for (int e = 0; e < 8; ++e) ss += x[e] * x[e];
            ss += __shfl_xor(ss, 1); ss += __shfl_xor(ss, 2); ss += __shfl_xor(ss, 4); ss += __shfl_xor(ss, 8);
            const float r = 1.f / sqrtf(ss * (1.f / 128.f) + RMS_EPS);
            float y[8];
#pragma unroll
            for (int e = 0; e < 8; ++e) { y[e] = x[e] * r * (hh < 8 ? gq[e] : gk[e]); }
#pragma unroll
            for (int e = 0; e < 8; ++e) { const float py = __shfl_xor(y[e], 4); x[e] = y[e] * cs[e] + py * sn[e]; }
            v4u o; o.x = cvtpk(x[0], x[1]); o.y = cvtpk(x[2], x[3]); o.z = cvtpk(x[4], x[5]); o.w = cvtpk(x[6], x[7]);
            *(v4u*)p = o;
        }
    }
}
__device__ __forceinline__ void attn_phase(Ctx& F) {
    bf16_t* Q = (bf16_t*)(F.ws + WS_Q); const attn::bf16* Kb = (const attn::bf16*)(F.ws + WS_K); const attn::bf16* Vb = (const attn::bf16*)(F.ws + WS_V);
    for (int uid = F.bid; uid < 2048 + 256; uid += F.G) {
        int row0, kv0, h, seq;
        if (uid < 2048) { const int g = uid & 3, qb = (uid >> 2) & 7, kvh = (uid >> 5) & 1, b = uid >> 6; h = kvh * 4 + g; row0 = b * SEQ + qb * 256; kv0 = b * KVS; seq = KVS; }
        else { const int u2 = uid - 2048; h = u2 & 7; const int b = u2 >> 3; row0 = ML + b * CTXL; kv0 = b * KVS + SEQ; seq = CTXL; }
        const int kvh = h >> 2;
        attn::attn_dense_body<attn::bf16>((const attn::bf16*)(Q + (size_t)row0 * DM + h * 128), Kb + (size_t)kv0 * 256 + kvh * 128, Vb + (size_t)kv0 * 256 + kvh * 128,
                                          Q + (size_t)row0 * DM + h * 128, seq, F.ldsg);
        __syncthreads();
    }
}
namespace ml {
constexpr int LDQ = 272, LDT = 144;
constexpr int OFF_QS = 0, OFF_QW = 17408, OFF_KS = 34816, OFF_KWT = 52224, OFF_VT = 70656, OFF_SW = 107520, OFF_VEC = 116736;
constexpr int VEC_STRIDE = 1296, OFF_RDN = OFF_VEC + 2 * VEC_STRIDE, OFF_N = OFF_RDN + 256, OFF_CW = OFF_N + 512, LDS_END = OFF_CW + 4096;
static_assert(LDS_END <= 131072, "mlstm lds");
__device__ __forceinline__ int crow(int r, int hi) { return (r & 3) + 8 * (r >> 2) + 4 * hi; }
}
__device__ __forceinline__ void mlstm_scan(Ctx& F, bf16_t* HD, const float* conv_w, const float* conv_b) {
    using namespace ml;
    const bf16_t* P = (const bf16_t*)(F.ws + WS_BIG); const float* G = (const float*)(F.ws + WS_G);
    LAS unsigned char* L = F.lds;
    const int lane = F.lane, w = F.wave, r32 = lane & 31, hi = lane >> 5;
    for (int unit = F.bid; unit < 256; unit += F.G) {
        const int b = unit >> 3, h = (unit >> 1) & 3, dir = unit & 1;
        f32x16 Cst[4];
#pragma unroll
        for (int dt = 0; dt < 4; ++dt)
#pragma unroll
            for (int r = 0; r < 16; ++r) Cst[dt][r] = 0.f;
        float nreg = 0.f, mst = 0.f;
        if (F.tid < 128) ((LAS float*)(L + OFF_N))[F.tid] = 0.f;
        for (int i = F.tid; i < 1024; i += NTHR) { const int j = i >> 8, ci = i & 255; const int ch = (ci < 128 ? 0 : 512 - 128) + h * 128 + ci;
            ((LAS float*)(L + OFF_CW))[i] = j < 3 ? conv_w[j * 1024 + ch] : conv_b[ch]; }
        __syncthreads();
        for (int c = 0; c < 36; ++c) {
            const bool isctx = c < 4;
            const int cc = isctx ? (dir ? 3 - c : c) : (dir ? 31 - (c - 4) : (c - 4));
            const int rowbase = isctx ? ML + b * CTXL + 64 * cc : b * SEQ + 64 * cc;
            const int t0 = 64 * cc, Lseq = isctx ? CTXL : SEQ;
            LAS float* vec = (LAS float*)(L + OFF_VEC + (c & 1) * VEC_STRIDE);
            if (w == 0) {
                const int ti = dir ? 63 - lane : lane; const float* gp = G + (size_t)(rowbase + ti) * 16;
                const float ig = gp[(2 * dir) * 4 + h], fg = gp[(2 * dir + 1) * 4 + h];
                const float fl = fminf(fg, 0.f) - log1pf(expf(-fabsf(fg)));
                float bc = fl;
#pragma unroll
                for (int o = 1; o < 64; o <<= 1) { const float t = __shfl_up(bc, o); if (lane >= o) bc += t; }
                const float a = ig - bc; float pm = a;
#pragma unroll
                for (int o = 1; o < 64; o <<= 1) { const float t = __shfl_up(pm, o); if (lane >= o) pm = fmaxf(pm, t); }
                const float M = fmaxf(mst, pm);
                const float Mlast = __shfl(M, 63), blast = __shfl(bc, 63);
                vec[ti] = a; vec[64 + ti] = M; vec[128 + ti] = expf(mst - M); vec[192 + ti] = bc + M; vec[256 + ti] = expf(a - Mlast);
                if (lane == 0) vec[320] = expf(mst - Mlast);
                mst = blast + Mlast;
            }
            __syncthreads();
            {
                const int ti = lane, row = rowbase + ti, t = t0 + ti;
                const bool hasp = t >= 1, hasn = t + 1 < Lseq;
                const bf16_t* prow = P + (size_t)row * PLD;
                const float wi = vec[128 + ti], wk = vec[256 + ti];
                if (!(isctx && w < 4)) {
                    const bool isq = w < 4; const int dbase = 32 * (w & 3); const int cbase = (isq ? 0 : 512) + h * 128 + dbase;
#pragma unroll
                    for (int g8 = 0; g8 < 4; ++g8) {
                        const int ch = cbase + 8 * g8;
                        const v4u cur = *(const v4u*)(prow + ch);
                        v4u prv = {0u, 0u, 0u, 0u}, nxt = {0u, 0u, 0u, 0u};
                        if (hasp) prv = *(const v4u*)(prow - PLD + ch);
                        if (hasn) nxt = *(const v4u*)(prow + PLD + ch);
                        float y[8];
#pragma unroll
                        for (int e2 = 0; e2 < 4; ++e2) {
                            const unsigned pc = e2 == 0 ? prv.x : e2 == 1 ? prv.y : e2 == 2 ? prv.z : prv.w;
                            const unsigned cu = e2 == 0 ? cur.x : e2 == 1 ? cur.y : e2 == 2 ? cur.z : cur.w;
                            const unsigned nx = e2 == 0 ? nxt.x : e2 == 1 ? nxt.y : e2 == 2 ? nxt.z : nxt.w;
                            const LAS float* cw = (const LAS float*)(L + OFF_CW) + (isq ? 0 : 128) + dbase + 8 * g8 + 2 * e2;
                            y[2 * e2] = cw[0] * bflo(pc) + cw[256] * bflo(cu) + cw[512] * bflo(nx) + cw[768];
                            y[2 * e2 + 1] = cw[1] * bfhi(pc) + cw[257] * bfhi(cu) + cw[513] * bfhi(nx) + cw[769];
                        }
#pragma unroll
                        for (int e = 0; e < 8; ++e) y[e] = siluf(y[e]);
                        const int dd = dbase + 8 * g8;
                        if (isq) {
                            v4u o; o.x = cvtpk(y[0], y[1]); o.y = cvtpk(y[2], y[3]); o.z = cvtpk(y[4], y[5]); o.w = cvtpk(y[6], y[7]);
                            *(LAS v4u*)(L + OFF_QS + ti * LDQ + dd * 2) = o;
                            o.x = cvtpk(y[0] * wi, y[1] * wi); o.y = cvtpk(y[2] * wi, y[3] * wi); o.z = cvtpk(y[4] * wi, y[5] * wi); o.w = cvtpk(y[6] * wi, y[7] * wi);
                            *(LAS v4u*)(L + OFF_QW + ti * LDQ + dd * 2) = o;
                        } else {
#pragma unroll
                            for (int e = 0; e < 8; ++e) y[e] *= 0.08838834764831845f;
                            v4u o; o.x = cvtpk(y[0], y[1]); o.y = cvtpk(y[2], y[3]); o.z = cvtpk(y[4], y[5]); o.w = cvtpk(y[6], y[7]);
                            *(LAS v4u*)(L + OFF_KS + ti * LDQ + dd * 2) = o;
#pragma unroll
                            for (int e = 0; e < 8; ++e) *(LAS unsigned short*)(L + OFF_KWT + (dd + e) * LDT + ti * 2) = (unsigned short)(cvtpk(y[e] * wk, 0.f) & 0xffffu);
                        }
                    }
                }
#pragma unroll
                for (int g8 = 0; g8 < 4; ++g8) {
                    const int vv = 32 * w + 8 * g8;
                    const v4u cur = *(const v4u*)(prow + 1024 + h * 256 + vv);
                    const unsigned ws4[4] = {cur.x, cur.y, cur.z, cur.w};
#pragma unroll
                    for (int e2 = 0; e2 < 4; ++e2) {
                        *(LAS unsigned short*)(L + OFF_VT + (vv + 2 * e2) * LDT + ti * 2) = (unsigned short)(ws4[e2] & 0xffffu);
                        *(LAS unsigned short*)(L + OFF_VT + (vv + 2 * e2 + 1) * LDT + ti * 2) = (unsigned short)(ws4[e2] >> 16);
                    }
                }
            }
            __syncthreads();
            if (!isctx) {
                if (w < 4) {
                    const int st = w & 1, tt = w >> 1;
                    f32x16 acc;
#pragma unroll
                    for (int r = 0; r < 16; ++r) acc[r] = 0.f;
                    const LAS unsigned char* ap = L + OFF_KS + (32 * st + r32) * LDQ + hi * 16;
                    const LAS unsigned char* bp = L + OFF_QS + (32 * tt + r32) * LDQ + hi * 16;
#pragma unroll
                    for (int ks = 0; ks < 8; ++ks) acc = __builtin_amdgcn_mfma_f32_32x32x16_bf16(*(const LAS bf16x8*)(ap + ks * 32), *(const LAS bf16x8*)(bp + ks * 32), acc, 0, 0, 0);
                    const int t = 32 * tt + r32, jt = dir ? 63 - t : t; const float Mt = vec[64 + t];
#pragma unroll
                    for (int q = 0; q < 4; ++q) {
                        float vals[4];
#pragma unroll
                        for (int e = 0; e < 4; ++e) { const int s = 32 * st + 8 * q + 4 * hi + e, js = dir ? 63 - s : s;
                            const float wgt = js <= jt ? __expf(vec[s] - Mt) : 0.f; vals[e] = acc[4 * q + e] * wgt; }
                        v2u o; o.x = cvtpk(vals[0], vals[1]); o.y = cvtpk(vals[2], vals[3]);
                        *(LAS v2u*)(L + OFF_SW + t * LDT + (32 * st + 8 * q + 4 * hi) * 2) = o;
                    }
                }
                __syncthreads();
                {
                    const int t = F.tid >> 3, p = F.tid & 7;
                    const v4u sw = *(const LAS v4u*)(L + OFF_SW + t * LDT + 16 * p);
                    float d = (bflo(sw.x) + bfhi(sw.x)) + (bflo(sw.y) + bfhi(sw.y)) + (bflo(sw.z) + bfhi(sw.z)) + (bflo(sw.w) + bfhi(sw.w));
                    const LAS float* nl = (const LAS float*)(L + OFF_N) + 16 * p;
#pragma unroll
                    for (int hq = 0; hq < 2; ++hq) { const v4u qw = *(const LAS v4u*)(L + OFF_QW + t * LDQ + 32 * p + 16 * hq); const LAS float* n8 = nl + 8 * hq;
                        d += bflo(qw.x) * n8[0] + bfhi(qw.x) * n8[1] + bflo(qw.y) * n8[2] + bfhi(qw.y) * n8[3] + bflo(qw.z) * n8[4] + bfhi(qw.z) * n8[5] + bflo(qw.w) * n8[6] + bfhi(qw.w) * n8[7]; }
                    d += __shfl_xor(d, 1); d += __shfl_xor(d, 2); d += __shfl_xor(d, 4);
                    if (p == 0) ((LAS float*)(L + OFF_RDN))[t] = 1.f / fmaxf(fabsf(d), expf(-vec[192 + t]));
                }
                __syncthreads();
                bf16x8 Cb[4][2];
#pragma unroll
                for (int dt = 0; dt < 4; ++dt)
#pragma unroll
                    for (int jp = 0; jp < 2; ++jp) { v4u o; o.x = cvtpk(Cst[dt][8 * jp + 0], Cst[dt][8 * jp + 1]); o.y = cvtpk(Cst[dt][8 * jp + 2], Cst[dt][8 * jp + 3]);
                        o.z = cvtpk(Cst[dt][8 * jp + 4], Cst[dt][8 * jp + 5]); o.w = cvtpk(Cst[dt][8 * jp + 6], Cst[dt][8 * jp + 7]); Cb[dt][jp] = __builtin_bit_cast(bf16x8, o); }
                const LAS unsigned char* vtp = L + OFF_VT + (32 * w + r32) * LDT + hi * 16;
#pragma unroll
                for (int tt = 0; tt < 2; ++tt) {
                    f32x16 acc;
#pragma unroll
                    for (int r = 0; r < 16; ++r) acc[r] = 0.f;
                    const LAS unsigned char* swp = L + OFF_SW + (32 * tt + r32) * LDT + hi * 16;
#pragma unroll
                    for (int ks = 0; ks < 4; ++ks) acc = __builtin_amdgcn_mfma_f32_32x32x16_bf16(*(const LAS bf16x8*)(swp + ks * 32), *(const LAS bf16x8*)(vtp + ks * 32), acc, 0, 0, 0);
                    const LAS unsigned char* qwp = L + OFF_QW + (32 * tt + r32) * LDQ + hi * 8;
#pragma unroll
                    for (int dt = 0; dt < 4; ++dt)
#pragma unroll
                        for (int jp = 0; jp < 2; ++jp) {
                            const v2u lo = *(const LAS v2u*)(qwp + (32 * dt + 16 * jp) * 2), hi2 = *(const LAS v2u*)(qwp + (32 * dt + 16 * jp + 8) * 2);
                            v4u av; av.x = lo.x; av.y = lo.y; av.z = hi2.x; av.w = hi2.y;
                            acc = __builtin_amdgcn_mfma_f32_32x32x16_bf16(__builtin_bit_cast(bf16x8, av), Cb[dt][jp], acc, 0, 0, 0);
                        }
                    const LAS float* rdn = (const LAS float*)(L + OFF_RDN);
#pragma unroll
                    for (int r = 0; r < 16; ++r) { const int t = 32 * tt + crow(r, hi);
                        HD[((size_t)dir * ML + rowbase + t) * DM + h * 256 + 32 * w + r32] = (bf16_t)(cvtpk(acc[r] * rdn[t], 0.f) & 0xffffu); }
                }
            }
            {
                const float decay = vec[320];
                const LAS unsigned char* vtp = L + OFF_VT + (32 * w + r32) * LDT + hi * 16;
                bf16x8 vb[4];
#pragma unroll
                for (int ks = 0; ks < 4; ++ks) vb[ks] = *(const LAS bf16x8*)(vtp + ks * 32);
#pragma unroll
                for (int dt = 0; dt < 4; ++dt) {
#pragma unroll
                    for (int r = 0; r < 16; ++r) Cst[dt][r] *= decay;
                    const LAS unsigned char* kp = L + OFF_KWT + (32 * dt + r32) * LDT + hi * 16;
#pragma unroll
                    for (int ks = 0; ks < 4; ++ks) Cst[dt] = __builtin_amdgcn_mfma_f32_32x32x16_bf16(*(const LAS bf16x8*)(kp + ks * 32), vb[ks], Cst[dt], 0, 0, 0);
                }
                if (F.tid < 128) {
                    float s = 0.f;
#pragma unroll
                    for (int i = 0; i < 8; ++i) { const v4u kw = *(const LAS v4u*)(L + OFF_KWT + F.tid * LDT + 16 * i);
                        s += (bflo(kw.x) + bfhi(kw.x)) + (bflo(kw.y) + bfhi(kw.y)) + (bflo(kw.z) + bfhi(kw.z)) + (bflo(kw.w) + bfhi(kw.w)); }
                    nreg = decay * nreg + s;
                    ((LAS float*)(L + OFF_N))[F.tid] = nreg;
                }
            }
        }
        __syncthreads();
    }
}
__device__ __forceinline__ void mlstm_readout(Ctx& F, const bf16_t* HD, const float* ng) {
    const bf16_t* P = (const bf16_t*)(F.ws + WS_BIG); bf16_t* A2 = (bf16_t*)(F.ws + WS_XM);
    const int gw = F.bid * NWAVES + F.wave, NGW = F.G * NWAVES;
    for (int row = gw; row < ML; row += NGW) {
        const int col = 16 * F.lane;
        float s[16], o[16];
#pragma unroll
        for (int i = 0; i < 2; ++i) {
            const v4u a = *(const v4u*)(HD + (size_t)row * DM + col + 8 * i), bq = *(const v4u*)(HD + ((size_t)ML + row) * DM + col + 8 * i), ov = *(const v4u*)(P + (size_t)row * PLD + 2048 + col + 8 * i);
            const unsigned aw[4] = {a.x, a.y, a.z, a.w}, bw[4] = {bq.x, bq.y, bq.z, bq.w}, ow[4] = {ov.x, ov.y, ov.z, ov.w};
#pragma unroll
            for (int e = 0; e < 4; ++e) { s[8 * i + 2 * e] = bflo(aw[e]) + bflo(bw[e]); s[8 * i + 2 * e + 1] = bfhi(aw[e]) + bfhi(bw[e]); o[8 * i + 2 * e] = bflo(ow[e]); o[8 * i + 2 * e + 1] = bfhi(ow[e]); }
        }
        float sum = 0.f;
#pragma unroll
        for (int e = 0; e < 16; ++e) sum += s[e];
        sum += __shfl_xor(sum, 1); sum += __shfl_xor(sum, 2); sum += __shfl_xor(sum, 4); sum += __shfl_xor(sum, 8);
        const float mu = sum * (1.f / 256.f); float q = 0.f;
#pragma unroll
        for (int e = 0; e < 16; ++e) { s[e] -= mu; q += s[e] * s[e]; }
        q += __shfl_xor(q, 1); q += __shfl_xor(q, 2); q += __shfl_xor(q, 4); q += __shfl_xor(q, 8);
        const float rstd = 1.f / sqrtf(q * (1.f / 256.f) + LN_EPS);
        float y[16];
#pragma unroll
        for (int e = 0; e < 16; ++e) y[e] = s[e] * rstd * ng[col + e] * __builtin_amdgcn_rcpf(1.f + __expf(-o[e]));
#pragma unroll
        for (int i = 0; i < 2; ++i) { v4u wv; wv.x = cvtpk(y[8 * i], y[8 * i + 1]); wv.y = cvtpk(y[8 * i + 2], y[8 * i + 3]); wv.z = cvtpk(y[8 * i + 4], y[8 * i + 5]); wv.w = cvtpk(y[8 * i + 6], y[8 * i + 7]);
            *(v4u*)(A2 + (size_t)row * DM + col + 8 * i) = wv; }
    }
}
constexpr int N_PHASES = 24;

template <class Epi>
__device__ __forceinline__ void run_gemm(Ctx& F, const bf16_t* A, const bf16_t* Bt, int M, int N, int K, const Epi& E) {
    pg8::Gemm g{A, Bt, M, N, K}; pg8::StaticOrder S; S.init(M, N, F.G, F.bid);
    pg8::gemm_phase<Epi, pg8::StaticOrder, true, true>(F.lds, g, S, E);
}

__global__ void __launch_bounds__(NTHR, 2) fwd_megakernel(Args args) {
    extern __shared__ __attribute__((aligned(16))) unsigned char lds_raw[];
    cg::grid_group grid = cg::this_grid();
    Ctx F;
    F.lds = (LAS unsigned char*)lds_raw; F.ldsg = (char*)lds_raw;
    relane(F);
#ifndef PH_LO
#define PH_LO 0
#endif
#ifndef PH_HI
#define PH_HI N_PHASES
#endif
    constexpr int lo = PH_LO, hi = PH_HI;
#ifndef CATS
#define CATS 0xff
#endif
#ifndef GSEL
#define GSEL 0xf
#endif
#define CAT_P0 ((CATS & 1) != 0)
#define CAT_ROW ((CATS & 2) != 0)
#define CAT_GEMM ((CATS & 4) != 0)
#define CAT_ATTN ((CATS & 8) != 0)
#define CAT_ML ((CATS & 16) != 0)
#define CAT_QKN ((CATS & 32) != 0)
#define IN(k) (lo <= (k) && (k) < hi)
#define SEAM(k) do { if (IN(k) && IN((k) + 1)) grid.sync(); } while (0)
#define H ((float*)(F.ws + WS_H))
#define XM ((bf16_t*)(F.ws + WS_XM))
#define BIG ((bf16_t*)(F.ws + WS_BIG))
#define MOD ((const float*)(F.ws + WS_MOD))
    const float* ln_g = ARG_IN(6); const float* ln_b = ARG_IN(7);

    if (CAT_P0 && IN(0)) { p0_weights(F, ARG_IN(8), ARG_IN(9), ARG_IN(10), ARG_IN(13), ARG_IN(14), ARG_IN(19)); __syncthreads(); p0_mods(F, ARG_IN(1), ARG_IN(3), ARG_IN(4), ARG_IN(5)); p0_rope(F); }
    SEAM(0);
    if (CAT_ROW && IN(1)) relane(F), row_pass<0>(F, ARG_IN(0), ARG_IN(2), MT, nullptr, nullptr, MOD, 0, 1);
    SEAM(1);
#pragma unroll
    for (int l = 0; l < 2; ++l) {
        const int pb = 2 + 11 * l;
#define MODl (MOD + (size_t)l * 33 * NMODC)
        const int Mmix = (l == 0) ? MT : ML;
        if (CAT_GEMM && IN(pb + 0)) { relane(F); EpiSwiglu E{BIG}; if (GSEL & 1) run_gemm(F, XM, (const bf16_t*)(F.ws + WS_W1 + (size_t)(2 * l) * W1_SZ), MT, NFF1, DM, E); }
        SEAM(pb + 0);
        if (CAT_GEMM && IN(pb + 1)) { relane(F); EpiResid E{l == 0 ? ARG_IN(0) : H, l == 0 ? ARG_IN(2) : H + (size_t)ML * DM, H, MODl + 2 * DM, 0.5f};
            if (GSEL & 2) run_gemm(F, BIG, (const bf16_t*)(F.ws + WS_W2 + (size_t)(2 * l) * W2_SZ), MT, DM, DFF, E); }
        SEAM(pb + 1);
        if (CAT_ROW && IN(pb + 2)) relane(F), row_pass<1>(F, nullptr, nullptr, MT, ln_g + (l * 3 + 0) * DM, ln_b + (l * 3 + 0) * DM, MODl, 3, 4);
        SEAM(pb + 2);
        if (l == 0) {
            if (CAT_GEMM && IN(pb + 3)) { relane(F); EpiQKV E{(bf16_t*)(F.ws + WS_Q), (bf16_t*)(F.ws + WS_K), (bf16_t*)(F.ws + WS_V)}; if (GSEL & 4) run_gemm(F, XM, (const bf16_t*)(F.ws + WS_WQKV), MT, NQKV, DM, E); }
            SEAM(pb + 3);
            if (CAT_QKN && IN(pb + 4)) relane(F), qknorm_rope(F, ARG_IN(11), ARG_IN(12));
            SEAM(pb + 4);
            if (CAT_ATTN && IN(pb + 5)) { relane(F); attn_phase(F); }
            SEAM(pb + 5);
            if (CAT_GEMM && IN(pb + 6)) { relane(F); EpiResid E{H, H + (size_t)ML * DM, H, MODl + 5 * DM, 1.0f}; if (GSEL & 2) run_gemm(F, (const bf16_t*)(F.ws + WS_Q), (const bf16_t*)(F.ws + WS_WOA), MT, DM, DM, E); }
            SEAM(pb + 6);
        } else {
            bf16_t* HD = (bf16_t*)F.out;
            if (CAT_GEMM && IN(pb + 3)) { relane(F); EpiMlIn E{BIG, (float*)(F.ws + WS_G), ARG_IN(15)}; if (GSEL & 8) run_gemm(F, XM, (const bf16_t*)(F.ws + WS_WMI), MT, NMLPAD, DM, E); }
            SEAM(pb + 3);
            if (CAT_ML && IN(pb + 4)) relane(F), mlstm_scan(F, HD, ARG_IN(16), ARG_IN(17));
            SEAM(pb + 4);
            if (CAT_ML && IN(pb + 5)) relane(F), mlstm_readout(F, HD, ARG_IN(18));
            SEAM(pb + 5);
            if (CAT_GEMM && IN(pb + 6)) { relane(F); EpiResid E{H, H + (size_t)ML * DM, H, MODl + 5 * DM, 1.0f}; if (GSEL & 2) run_gemm(F, XM, (const bf16_t*)(F.ws + WS_WMO), ML, DM, DM, E); }
            SEAM(pb + 6);
        }
        if (CAT_ROW && IN(pb + 7)) relane(F), row_pass<1>(F, nullptr, nullptr, Mmix, ln_g + (l * 3 + 1) * DM, ln_b + (l * 3 + 1) * DM, MODl, 6, 7);
        SEAM(pb + 7);
        if (CAT_GEMM && IN(pb + 8)) { relane(F); EpiSwiglu E{BIG}; if (GSEL & 1) run_gemm(F, XM, (const bf16_t*)(F.ws + WS_W1 + (size_t)(2 * l + 1) * W1_SZ), Mmix, NFF1, DM, E); }
        SEAM(pb + 8);
        if (CAT_GEMM && IN(pb + 9)) { relane(F); EpiResid E{H, H + (size_t)ML * DM, H, MODl + 8 * DM, 0.5f}; if (GSEL & 2) run_gemm(F, BIG, (const bf16_t*)(F.ws + WS_W2 + (size_t)(2 * l + 1) * W2_SZ), Mmix, DM, DFF, E); }
        SEAM(pb + 9);
        if (l == 0) { if (CAT_ROW && IN(pb + 10)) relane(F), row_pass<1>(F, nullptr, nullptr, MT, ln_g + 2 * DM, ln_b + 2 * DM, MOD + (size_t)33 * NMODC, 0, 1); }
        else        { if (CAT_ROW && IN(pb + 10)) relane(F), row_pass<2>(F, nullptr, nullptr, ML, ln_g + 5 * DM, ln_b + 5 * DM, MODl, 0, 1); }
        SEAM(pb + 10);
    }
#undef H
#undef XM
#undef BIG
#undef MOD
#undef MODl
#undef IN
#undef SEAM
}

extern "C" void kernel_launch(void* const* d_in, const int* in_sizes, int n_in, void* d_out, int out_size, void* d_ws, size_t ws_size, hipStream_t stream) {
    static int grid_blocks = 0;
    if (!grid_blocks) {
        if (n_in != 20 || out_size != ML * DM || ws_size < WS_END) { fprintf(stderr, "kernel_launch: unexpected shapes: n_in %d out %d ws %zu (need %zu)\n", n_in, out_size, ws_size, (size_t)WS_END); return; }
        int dev = 0, cus = 0, per_cu = 0;
        hipGetDevice(&dev);
        hipDeviceGetAttribute(&cus, hipDeviceAttributeMultiprocessorCount, dev);
        if (hipFuncSetAttribute((const void*)fwd_megakernel, hipFuncAttributeMaxDynamicSharedMemorySize, LDS_BYTES) != hipSuccess) { fprintf(stderr, "kernel_launch: hipFuncSetAttribute failed\n"); return; }
        hipOccupancyMaxActiveBlocksPerMultiprocessor(&per_cu, fwd_megakernel, NTHR, LDS_BYTES);
        if (per_cu < 1) { fprintf(stderr, "kernel_launch: occupancy query says 0 blocks per CU\n"); return; }
        grid_blocks = cus * 1;
    }
    Args a{};
    for (int i = 0; i < 20; ++i) a.in[i] = (const float*)d_in[i];
    a.out = (float*)d_out; a.ws = (unsigned char*)d_ws; a.ph_lo = 0; a.ph_hi = N_PHASES;
    void* kargs[] = {&a};
    hipError_t e = hipLaunchCooperativeKernel((const void*)fwd_megakernel, dim3(grid_blocks), dim3(NTHR), kargs, LDS_BYTES, stream);
    if (e != hipSuccess) fprintf(stderr, "cooperative launch failed: %s (grid %d)\n", hipGetErrorString(e), grid_blocks);
}
```

```cpp
#include <hip/hip_runtime.h>
#include <hip/hip_bf16.h>
#include <hip/hip_cooperative_groups.h>
#include <cstdio>
#include <cstdint>
namespace cg = cooperative_groups;
namespace pg8 {
#define PG8_LAS __attribute__((address_space(3)))
typedef unsigned short bf16_t;
typedef short bf16x8 __attribute__((ext_vector_type(8)));
typedef float f32x4 __attribute__((ext_vector_type(4)));
typedef unsigned u32x4 __attribute__((ext_vector_type(4)));
constexpr int BM = 256, BK = 64, HALF = 128, HTB = HALF * BK * 2  , STAGE_BYTES = 8 * HTB, NXCD = 8, WGM = 8;

__host__ __device__ __forceinline__ int lds_byte(int r, int c) { const int st = (r >> 4) * 2 + (c >> 5), rr = r & 15, cc = c & 31, ob = rr * 64 + cc * 2; return st * 1024 + (ob ^ (((ob >> 9) & 1) << 5)); }
__host__ __device__ __forceinline__ void stage_rc(int b, int& R, int& C) { const int st = b / 1024, sb = b % 1024, swz = sb ^ (((sb >> 9) & 1) << 5); R = (st >> 1) * 16 + swz / 64; C = (st & 1) * 32 + (swz % 64) / 2; }
__host__ __device__ __forceinline__ int perm32(int rho) { const int n = rho >> 4, i = rho & 15; return 8 * (i >> 2) + 4 * n + (i & 3); }

struct Unit { int pm, pn; };
struct Gemm { const bf16_t* A; const bf16_t* Bt; int M, N, K; };

struct StaticOrder {
    int nM, nN, nwg, G, c, rev, pm_off; unsigned long long pn_map;
    __host__ __device__ void init(int M, int N, int G_, int c_, int rev_ = 0, int pm_off_ = 0) { nM = M / BM; nN = N / BM; nwg = nM * nN; G = G_; c = c_; rev = rev_; pm_off = pm_off_; pn_map = 0ull; }
    __host__ __device__ bool next(int i, Unit& u) const {
        const long L = (long)i * G + c; if (L >= nwg) return false;
        int wgid = (int)L; { const int q = nwg / NXCD, r = nwg % NXCD, xcd = wgid % NXCD, off = wgid / NXCD; wgid = (xcd < r ? xcd * (q + 1) : r * (q + 1) + (xcd - r) * q) + off; }
        const int nig = WGM * nN, gid = wgid / nig, fm = gid * WGM, gsz = (nM - fm) < WGM ? (nM - fm) : WGM;
        u.pm = fm + ((wgid % nig) % gsz); u.pn = (wgid % nig) / gsz; if (rev) u.pm = nM - 1 - u.pm; u.pm += pm_off; if (pn_map) u.pn = (int)((pn_map >> (4 * u.pn)) & 15ull); return true;
    }
    __device__ __forceinline__ void a_ready(const Unit&) const {}
    __device__ __forceinline__ void done(const Unit&) const {}
};

__device__ __forceinline__ unsigned cvt_pk_bf16(float lo, float hi) { unsigned r; asm volatile("v_cvt_pk_bf16_f32 %0, %1, %2" : "=v"(r) : "v"(lo), "v"(hi)); return r; }
typedef float f32x2 __attribute__((ext_vector_type(2)));
__device__ __forceinline__ f32x2 gelu_pk(f32x2 v) {
    const f32x2 av = __builtin_elementwise_abs(v), d = av * 0.2316418882f + 1.0f;
    f32x2 t; t.x = __builtin_amdgcn_rcpf(d.x); t.y = __builtin_amdgcn_rcpf(d.y);
    f32x2 q = t * 0.5307027145f + (-0.7265760135f); q = q * t + 0.7107068705f; q = q * t + (-0.142248368f); q = q * t + 0.127414796f; q = q * t;
    const f32x2 s = (v * v) * (-0.72134752044f);
    f32x2 e; e.x = __builtin_amdgcn_exp2f(s.x); e.y = __builtin_amdgcn_exp2f(s.y);
    const f32x2 m = v * (q * e), r = v - m;
    f32x2 o; o.x = v.x < 0.f ? m.x : r.x; o.y = v.y < 0.f ? m.y : r.y; return o;
}

template <int ACT  > struct EpiBf16 {
    static constexpr bool PERM = true, AFTER_DRAIN = false; static_assert(ACT == 0 || ACT == 1, "EpiBf16: ACT is 0 (none) or 1 (gelu_pk)");
    bf16_t* O; int ldc; const float* bias; int split_cols; size_t split_stride; float scale0;
    __device__ __forceinline__ void operator()(const f32x4 (&acc)[2][2][4][2], const Unit& u, int wr, int wc, int fr, int fq) const {
        const int row0 = u.pm * BM + wr * 64 + fr; int colt = u.pn * BM; bf16_t* base = O;
        float sc = 1.f; if (split_cols) { const int t = colt / split_cols; base += (size_t)t * split_stride; colt -= t * split_cols; if (t == 0) sc = scale0; }
        const int col0 = colt + wc * 32 + 8 * fq, bcol0 = u.pn * BM + wc * 32 + 8 * fq;
        f32x4 bv[2][2];
#pragma unroll
        for (int bj = 0; bj < 2; ++bj)
#pragma unroll
            for (int n = 0; n < 2; ++n) bv[bj][n] = bias ? *(const f32x4*)(bias + bcol0 + bj * HALF + 4 * n) : (f32x4){0.f, 0.f, 0.f, 0.f};
#pragma unroll
        for (int ai = 0; ai < 2; ++ai)
#pragma unroll
            for (int m = 0; m < 4; ++m) { bf16_t* rowp = base + (size_t)(row0 + ai * HALF + m * 16) * ldc + col0;
#pragma unroll
                for (int bj = 0; bj < 2; ++bj) { f32x4 v0 = acc[ai][bj][m][0] + bv[bj][0], v1 = acc[ai][bj][m][1] + bv[bj][1];
                    if (ACT == 1) { f32x2 a = gelu_pk((f32x2){v0[0], v0[1]}), b = gelu_pk((f32x2){v0[2], v0[3]}), c = gelu_pk((f32x2){v1[0], v1[1]}), d = gelu_pk((f32x2){v1[2], v1[3]});
                        v0 = (f32x4){a.x, a.y, b.x, b.y}; v1 = (f32x4){c.x, c.y, d.x, d.y}; }
                    v0 = v0 * sc; v1 = v1 * sc; u32x4 w; w.x = cvt_pk_bf16(v0[0], v0[1]); w.y = cvt_pk_bf16(v0[2], v0[3]); w.z = cvt_pk_bf16(v1[0], v1[1]); w.w = cvt_pk_bf16(v1[2], v1[3]);
                    *(u32x4*)(rowp + bj * HALF) = w; } }
    }
};

struct PanelStats {
    unsigned* xbuf;
    unsigned* cnt;
    unsigned* tmo;
    int ntn; float eps;
    unsigned code;
    __device__ __forceinline__ bool run(const f32x4 (&v)[2][2][4][2], const Unit& u, int wr, int wc, int fr, int fq, PG8_LAS unsigned char* lds, int wid, int lane) const {
        typedef float f32x2v __attribute__((ext_vector_type(2)));
        PG8_LAS f32x2v* P = (PG8_LAS f32x2v*)lds;
        PG8_LAS f32x2v* S = (PG8_LAS f32x2v*)(lds + 8192);
        PG8_LAS unsigned* flag = (PG8_LAS unsigned*)(lds + 8192 + 2048);
#pragma unroll
        for (int ai = 0; ai < 2; ++ai)
#pragma unroll
            for (int m = 0; m < 4; ++m) {
                float s = 0.f;
#pragma unroll
                for (int bj = 0; bj < 2; ++bj)
#pragma unroll
                    for (int n = 0; n < 2; ++n) { const f32x4 x = v[ai][bj][m][n]; s += (x[0] + x[1]) + (x[2] + x[3]); }
                s += __shfl_xor(s, 16); s += __shfl_xor(s, 32);
                const float mw = s * (1.0f / 64.0f); float q = 0.f;
#pragma unroll
                for (int bj = 0; bj < 2; ++bj)
#pragma unroll
                    for (int n = 0; n < 2; ++n) { const f32x4 d = v[ai][bj][m][n] - mw; q += (d[0] * d[0] + d[1] * d[1]) + (d[2] * d[2] + d[3] * d[3]); }
                q += __shfl_xor(q, 16); q += __shfl_xor(q, 32);
                if (fq == 0) P[(ai * HALF + wr * 64 + m * 16 + fr) * 4 + wc] = (f32x2v){mw, q};
            }
        asm volatile("s_waitcnt lgkmcnt(0)" ::: "memory"); __builtin_amdgcn_s_barrier(); asm volatile("" ::: "memory");
#if defined(BROKEN_EXCHANGE_NO_WAIT)
#warning BROKEN CONTROL BUILD: the row-statistics exchange does not wait; results are wrong by design
        if (blockIdx.x >= 64) { const long long t0_ = clock64(); while (clock64() - t0_ < 60000) __builtin_amdgcn_s_sleep(8); }
#endif
        const int row = wid * 32 + (lane & 31);
        if (lane < 32) {
            const f32x2v a = P[row * 4 + 0], b = P[row * 4 + 1], c = P[row * 4 + 2], d = P[row * 4 + 3];
            const float mt = (a.x + b.x + c.x + d.x) * 0.25f;
            const float da = a.x - mt, db = b.x - mt, dc = c.x - mt, dd = d.x - mt;
            const float m2 = (a.y + b.y) + (c.y + d.y) + 64.0f * ((da * da + db * db) + (dc * dc + dd * dd));
            unsigned long long* slot = (unsigned long long*)xbuf + ((size_t)(u.pm * BM + row) * 4 + u.pn);
            __hip_atomic_store(slot, ((unsigned long long)__float_as_uint(m2) << 32) | __float_as_uint(mt), __ATOMIC_RELAXED, __HIP_MEMORY_SCOPE_AGENT);
        }
        asm volatile("s_waitcnt vmcnt(0)" ::: "memory");
        if (lane == 0) __hip_atomic_fetch_add(cnt + 64 * u.pm, 1u, __ATOMIC_RELAXED, __HIP_MEMORY_SCOPE_AGENT);
        if (wid == 0) {
            bool dead = false; const unsigned long long t0 = __builtin_amdgcn_s_memrealtime(); const unsigned want = 8u * (unsigned)ntn;
            for (;;) {
#if defined(BROKEN_EXCHANGE_NO_WAIT)
                break;
#endif
                if ((unsigned)__builtin_amdgcn_readfirstlane(__hip_atomic_load(cnt + 64 * u.pm, __ATOMIC_RELAXED, __HIP_MEMORY_SCOPE_AGENT)) >= want) break;
                if (__builtin_amdgcn_s_memrealtime() - t0 > 2000000ull) {
                    if (lane == 0) { unsigned expect = 0u; __hip_atomic_compare_exchange_strong(tmo + 1, &expect, code | (unsigned)(u.pm & 0xff), __ATOMIC_RELAXED, __ATOMIC_RELAXED, __HIP_MEMORY_SCOPE_AGENT);
                                     __hip_atomic_store(tmo, 1u, __ATOMIC_RELAXED, __HIP_MEMORY_SCOPE_AGENT); }
                    dead = true; break; }
                __builtin_amdgcn_s_sleep(2);
            }
            __builtin_amdgcn_fence(__ATOMIC_ACQUIRE, "agent");
            if (lane == 0) flag[0] = dead ? 1u : 0u;
        }
        asm volatile("s_waitcnt vmcnt(0) lgkmcnt(0)" ::: "memory"); __builtin_amdgcn_s_barrier(); asm volatile("" ::: "memory");
        const bool bad = flag[0] != 0u;
        if (lane < 32) {
            const unsigned long long* slot = (const unsigned long long*)xbuf + (size_t)(u.pm * BM + row) * 4; float mt[4], m2[4]; float ms = 0.f;
#pragma unroll
            for (int t = 0; t < 4; ++t) { if (t < ntn) { const unsigned long long w = __hip_atomic_load(slot + t, __ATOMIC_RELAXED, __HIP_MEMORY_SCOPE_AGENT); mt[t] = __uint_as_float((unsigned)w); m2[t] = __uint_as_float((unsigned)(w >> 32)); } else { mt[t] = 0.f; m2[t] = 0.f; } ms += mt[t]; }
            const float mean = ms / (float)ntn; float q = 0.f;
#pragma unroll
            for (int t = 0; t < 4; ++t) if (t < ntn) { const float dm = mt[t] - mean; q += m2[t] + 256.0f * dm * dm; }
            S[row] = (f32x2v){mean, 1.0f / sqrtf(q / (256.0f * (float)ntn) + eps)};
        }
        asm volatile("s_waitcnt lgkmcnt(0)" ::: "memory"); __builtin_amdgcn_s_barrier(); asm volatile("" ::: "memory");
        return bad;
    }
};
struct EpiLnRes {
    static constexpr bool PERM = false, AFTER_DRAIN = true;
    const float* base; float* out; int ldc; const float* bias; PanelStats st; unsigned poison;
    __device__ __forceinline__ void fused(f32x4 (&acc)[2][2][4][2], const Unit& u, int wr, int wc, int fr, int fq, PG8_LAS unsigned char* lds, int wid, int lane) const {
        typedef float f32x2v __attribute__((ext_vector_type(2)));
        const PG8_LAS f32x2v* S = (const PG8_LAS f32x2v*)(lds + 8192);
        const int col0 = u.pn * BM + wc * 32 + 4 * fq;
#pragma unroll
        for (int bj = 0; bj < 2; ++bj)
#pragma unroll
            for (int n = 0; n < 2; ++n) { const f32x4 bv = bias ? *(const f32x4*)(bias + col0 + bj * HALF + n * 16) : (f32x4){0.f, 0.f, 0.f, 0.f};
#pragma unroll
                for (int ai = 0; ai < 2; ++ai)
#pragma unroll
                    for (int m = 0; m < 4; ++m) acc[ai][bj][m][n] += bv; }
        f32x4 pre[4][2][2];
#pragma unroll
        for (int m = 0; m < 4; ++m) { const size_t off = (size_t)(u.pm * BM + wr * 64 + m * 16 + fr) * ldc + col0;
#pragma unroll
            for (int bj = 0; bj < 2; ++bj)
#pragma unroll
                for (int n = 0; n < 2; ++n) pre[m][bj][n] = *(const f32x4*)(base + off + bj * HALF + n * 16); }
        const bool bad = st.run(acc, u, wr, wc, fr, fq, lds, wid, lane) || poison != 0u;
        const float qnan = __builtin_nanf("");
#pragma unroll
        for (int ai = 0; ai < 2; ++ai)
#pragma unroll
            for (int m = 0; m < 4; ++m) { const int r = ai * HALF + wr * 64 + m * 16 + fr; const f32x2v sr = S[r]; const size_t off = (size_t)(u.pm * BM + r) * ldc + col0;
#pragma unroll
                for (int bj = 0; bj < 2; ++bj)
#pragma unroll
                    for (int n = 0; n < 2; ++n) { const f32x4 bs = ai == 0 ? pre[m][bj][n] : *(const f32x4*)(base + off + bj * HALF + n * 16); f32x4 o = bs + (acc[ai][bj][m][n] - sr.x) * sr.y;
                        if (bad) o = (f32x4){qnan, qnan, qnan, qnan}; *(f32x4*)(out + off + bj * HALF + n * 16) = o; }
                if (m & 1) asm volatile("" ::: "memory"); }
    }
};
struct EpiLnResLn {
    static constexpr bool PERM = false, AFTER_DRAIN = true;
    const float* base; float* out; bf16_t* xn; int ldc; const float* bias; PanelStats st1, st2; unsigned poison;
    __device__ __forceinline__ void fused(f32x4 (&acc)[2][2][4][2], const Unit& u, int wr, int wc, int fr, int fq, PG8_LAS unsigned char* lds, int wid, int lane) const {
        typedef float f32x2v __attribute__((ext_vector_type(2))); typedef unsigned u32x2v __attribute__((ext_vector_type(2)));
        const PG8_LAS f32x2v* S = (const PG8_LAS f32x2v*)(lds + 8192);
        const int col0 = u.pn * BM + wc * 32 + 4 * fq;
#pragma unroll
        for (int bj = 0; bj < 2; ++bj)
#pragma unroll
            for (int n = 0; n < 2; ++n) { const f32x4 bv = bias ? *(const f32x4*)(bias + col0 + bj * HALF + n * 16) : (f32x4){0.f, 0.f, 0.f, 0.f};
#pragma unroll
                for (int ai = 0; ai < 2; ++ai)
#pragma unroll
                    for (int m = 0; m < 4; ++m) acc[ai][bj][m][n] += bv; }
        bool bad = st1.run(acc, u, wr, wc, fr, fq, lds, wid, lane) || poison != 0u;
        const float qnan = __builtin_nanf("");
#pragma unroll
        for (int ai = 0; ai < 2; ++ai)
#pragma unroll
            for (int m = 0; m < 4; ++m) { const int r = ai * HALF + wr * 64 + m * 16 + fr; const f32x2v sr = S[r]; const size_t off = (size_t)(u.pm * BM + r) * ldc + col0;
#pragma unroll
                for (int bj = 0; bj < 2; ++bj)
#pragma unroll
                    for (int n = 0; n < 2; ++n) { const f32x4 bs = *(const f32x4*)(base + off + bj * HALF + n * 16); acc[ai][bj][m][n] = bs + (acc[ai][bj][m][n] - sr.x) * sr.y; }
                asm volatile("" : "+v"(acc[ai][0][m][0]), "+v"(acc[ai][0][m][1]), "+v"(acc[ai][1][m][0]), "+v"(acc[ai][1][m][1]));
                if (m & 1) asm volatile("" ::: "memory"); }
        const bool bad1 = bad;
        bad = st2.run(acc, u, wr, wc, fr, fq, lds, wid, lane) || bad;
#pragma unroll
        for (int ai = 0; ai < 2; ++ai)
#pragma unroll
            for (int m = 0; m < 4; ++m) { const int r = ai * HALF + wr * 64 + m * 16 + fr; const f32x2v sr = S[r]; const size_t off = (size_t)(u.pm * BM + r) * ldc + col0;
#pragma unroll
                for (int bj = 0; bj < 2; ++bj)
#pragma unroll
                    for (int n = 0; n < 2; ++n) { const f32x4 x1 = acc[ai][bj][m][n]; *(f32x4*)(out + off + bj * HALF + n * 16) = bad1 ? (f32x4){qnan, qnan, qnan, qnan} : x1;
                        const f32x4 o = (x1 - sr.x) * sr.y; u32x2v w; w.x = cvt_pk_bf16(o[0], o[1]); w.y = cvt_pk_bf16(o[2], o[3]);
                        if (bad) { w.x = 0x7fc07fc0u; w.y = 0x7fc07fc0u; } *(u32x2v*)(xn + off + bj * HALF + n * 16) = w; }
                asm volatile("" ::: "memory"); }
    }
};

template <class Epi, class Sched, bool ALIGN_EPI = false, bool SP2 = false>
__device__ __forceinline__ void gemm_phase(PG8_LAS unsigned char* lds, const Gemm g, const Sched& S, const Epi& E) {
    int tid_ = threadIdx.x; asm volatile("" : "+v"(tid_));
    const int tid = tid_, wid = __builtin_amdgcn_readfirstlane(tid >> 6), lane = tid & 63, wr = wid >> 2, wc = wid & 3, fr = lane & 15, fq = lane >> 4;
    const int K = g.K, nt = K / BK;
    unsigned voffA[2], voffB[2];
#pragma unroll
    for (int i = 0; i < 2; ++i) { int R, C; stage_rc(tid * 16 + i * 8192, R, C); const int Rb = Epi::PERM ? ((R & ~31) + perm32(R & 31)) : R;
        voffA[i] = (unsigned)(R * K + C) * 2u; voffB[i] = (unsigned)(Rb * K + C) * 2u; }
    const size_t kstep = (size_t)(BK * 2);
    const size_t hstep = (size_t)HALF * K * 2;
    const size_t tstep = 2 * hstep;
    const unsigned ldsw = (unsigned)wid * 1024u;
    const int aoff = lds_byte(wr * 64 + fr, fq * 8), boff = lds_byte(wc * 32 + fr, fq * 8);
#define PG8_SA(b, h) (((b) * 2 + (h)) * HTB)
#define PG8_SB(b, h) ((4 + (b) * 2 + (h)) * HTB)
#define PG8_STAGE(bufoff, gbase, voff) do { _Pragma("unroll") for (int _i = 0; _i < 2; ++_i) \
        __builtin_amdgcn_global_load_lds((const unsigned*)((const char*)(gbase) + (voff)[_i]), (PG8_LAS unsigned*)(lds + (bufoff) + ldsw + _i * 8192), 16, 0, 0); } while (0)
#define PG8_LDA(dst, b, h) do { _Pragma("unroll") for (int m = 0; m < 4; ++m) _Pragma("unroll") for (int k = 0; k < 2; ++k) dst[m][k] = *(const PG8_LAS bf16x8*)(lds + PG8_SA(b, h) + aoff + m * 2048 + k * 1024); } while (0)
#define PG8_LDB(dst, b, h) do { _Pragma("unroll") for (int n = 0; n < 2; ++n) _Pragma("unroll") for (int k = 0; k < 2; ++k) dst[n][k] = *(const PG8_LAS bf16x8*)(lds + PG8_SB(b, h) + boff + n * 2048 + k * 1024); } while (0)
#define PG8_MMA(ai, bj, At, Bt) do { __builtin_amdgcn_s_setprio(1); _Pragma("unroll") for (int m = 0; m < 4; ++m) _Pragma("unroll") for (int n = 0; n < 2; ++n) _Pragma("unroll") for (int k = 0; k < 2; ++k) \
        acc[ai][bj][m][n] = __builtin_amdgcn_mfma_f32_16x16x32_bf16(Bt[n][k], At[m][k], acc[ai][bj][m][n], 0, 0, 0); __builtin_amdgcn_s_setprio(0); } while (0)
#define PG8_WAIT_V(n) asm volatile("s_waitcnt vmcnt(" #n ")" ::: "memory")
#define PG8_WAIT_L(n) asm volatile("s_waitcnt lgkmcnt(" #n ")" ::: "memory")
#define PG8_BAR __builtin_amdgcn_s_barrier()
#define PG8_SCHED __builtin_amdgcn_sched_barrier(0)
    Unit cur, nxt; int ui = 0;
    if (!S.next(0, cur)) return;
    f32x4 acc[2][2][4][2];
#pragma unroll
    for (int a = 0; a < 2; ++a)
#pragma unroll
        for (int b = 0; b < 2; ++b)
#pragma unroll
            for (int m = 0; m < 4; ++m)
#pragma unroll
                for (int n = 0; n < 2; ++n) acc[a][b][m][n] = (f32x4){0.f, 0.f, 0.f, 0.f};
    bf16x8 At[4][2], B0[2][2], B1[2][2];
    const char* cA = (const char*)g.A + (size_t)cur.pm * tstep; const char* cB = (const char*)g.Bt + (size_t)cur.pn * tstep;
    S.a_ready(cur);
    if constexpr (SP2) {
        PG8_STAGE(PG8_SB(0, 0), cB, voffB); PG8_STAGE(PG8_SB(0, 1), cB + hstep, voffB); PG8_STAGE(PG8_SA(0, 0), cA, voffA); PG8_STAGE(PG8_SA(0, 1), cA + hstep, voffA);
        if (wr == 1) PG8_BAR;
        PG8_WAIT_V(2); PG8_BAR;
        PG8_STAGE(PG8_SB(1, 0), cB + kstep, voffB); PG8_STAGE(PG8_SA(1, 0), cA + kstep, voffA); PG8_STAGE(PG8_SB(1, 1), cB + hstep + kstep, voffB);
        PG8_WAIT_V(6); PG8_BAR;
    } else {
        PG8_STAGE(PG8_SB(0, 0), cB, voffB); PG8_STAGE(PG8_SA(0, 0), cA, voffA); PG8_STAGE(PG8_SB(0, 1), cB + hstep, voffB); PG8_STAGE(PG8_SA(0, 1), cA + hstep, voffA);
        if (wr == 1) PG8_BAR;
        PG8_WAIT_V(4); PG8_BAR;
        PG8_STAGE(PG8_SB(1, 0), cB + kstep, voffB); PG8_STAGE(PG8_SA(1, 0), cA + kstep, voffA); PG8_STAGE(PG8_SB(1, 1), cB + hstep + kstep, voffB);
        PG8_WAIT_V(6); PG8_BAR;
    }
    for (;;) {
        const bool has_next = S.next(ui + 1, nxt);
        const char* nA = has_next ? (const char*)g.A + (size_t)nxt.pm * tstep : cA; const char* nB = has_next ? (const char*)g.Bt + (size_t)nxt.pn * tstep : cB;
        for (int t = 0; t < nt; t += 2) {
            const bool last = (t == nt - 2);
            const char* a1 = cA + (size_t)(t + 1) * kstep;
            const char* a2 = last ? nA : cA + (size_t)(t + 2) * kstep; const char* b2 = last ? nB : cB + (size_t)(t + 2) * kstep;
            const char* a3 = a2 + kstep; const char* b3 = b2 + kstep;
            if (last && has_next) S.a_ready(nxt);
            if constexpr (SP2) {
            PG8_LDB(B0, 0, 0); PG8_LDB(B1, 0, 1); PG8_SCHED; PG8_LDA(At, 0, 0); PG8_STAGE(PG8_SA(1, 1), a1 + hstep, voffA);
            PG8_WAIT_V(8); PG8_WAIT_L(0); PG8_BAR; PG8_MMA(0, 0, At, B0); PG8_MMA(0, 1, At, B1); PG8_BAR; PG8_SCHED;
            PG8_LDA(At, 0, 1); PG8_STAGE(PG8_SB(0, 0), b2, voffB); PG8_STAGE(PG8_SB(0, 1), b2 + hstep, voffB); PG8_STAGE(PG8_SA(0, 0), a2, voffA);
            PG8_WAIT_V(8); PG8_WAIT_L(0); PG8_BAR; PG8_MMA(1, 0, At, B0); PG8_MMA(1, 1, At, B1); PG8_BAR; PG8_SCHED;
            PG8_LDB(B0, 1, 0); PG8_LDB(B1, 1, 1); PG8_SCHED; PG8_LDA(At, 1, 0); PG8_STAGE(PG8_SA(0, 1), a2 + hstep, voffA);
            PG8_WAIT_V(8); PG8_WAIT_L(0); PG8_BAR; PG8_MMA(0, 0, At, B0); PG8_MMA(0, 1, At, B1); PG8_BAR; PG8_SCHED;
            PG8_LDA(At, 1, 1); PG8_STAGE(PG8_SB(1, 0), b3, voffB); PG8_STAGE(PG8_SB(1, 1), b3 + hstep, voffB); PG8_STAGE(PG8_SA(1, 0), a3, voffA);
            PG8_WAIT_V(8); PG8_WAIT_L(0); PG8_BAR; PG8_MMA(1, 0, At, B0); PG8_MMA(1, 1, At, B1); PG8_BAR; PG8_SCHED;
            } else {
            PG8_LDB(B0, 0, 0); PG8_SCHED; PG8_LDA(At, 0, 0); PG8_STAGE(PG8_SA(1, 1), a1 + hstep, voffA);
            PG8_WAIT_L(8); PG8_BAR; PG8_WAIT_L(0); PG8_MMA(0, 0, At, B0); PG8_BAR; PG8_SCHED;
            PG8_LDB(B1, 0, 1); PG8_STAGE(PG8_SB(0, 0), b2, voffB);
            PG8_BAR; PG8_WAIT_L(0); PG8_MMA(0, 1, At, B1); PG8_BAR;
            PG8_LDA(At, 0, 1); PG8_STAGE(PG8_SA(0, 0), a2, voffA);
            PG8_BAR; PG8_WAIT_L(0); PG8_MMA(1, 0, At, B0); PG8_BAR; PG8_SCHED;
            PG8_STAGE(PG8_SB(0, 1), b2 + hstep, voffB);
            PG8_WAIT_V(6); PG8_BAR; PG8_MMA(1, 1, At, B1); PG8_BAR;
            PG8_LDB(B0, 1, 0); PG8_SCHED; PG8_LDA(At, 1, 0); PG8_STAGE(PG8_SA(0, 1), a2 + hstep, voffA);
            PG8_WAIT_L(8); PG8_BAR; PG8_WAIT_L(0); PG8_MMA(0, 0, At, B0); PG8_BAR; PG8_SCHED;
            PG8_LDB(B1, 1, 1); PG8_STAGE(PG8_SB(1, 0), b3, voffB);
            PG8_BAR; PG8_WAIT_L(0); PG8_MMA(0, 1, At, B1); PG8_BAR;
            PG8_LDA(At, 1, 1); PG8_STAGE(PG8_SA(1, 0), a3, voffA);
            PG8_BAR; PG8_WAIT_L(0); PG8_MMA(1, 0, At, B0); PG8_BAR; PG8_SCHED;
            PG8_STAGE(PG8_SB(1, 1), b3 + hstep, voffB);
            PG8_WAIT_V(6); PG8_BAR; PG8_MMA(1, 1, At, B1); PG8_BAR;
            }
        }
        if constexpr (ALIGN_EPI) { if (wr == 0) PG8_BAR; }
        if constexpr (!Epi::AFTER_DRAIN) { E(acc, cur, wr, wc, fr, fq); S.done(cur); }
        if (!has_next) break;
#pragma unroll
        for (int a = 0; a < 2; ++a)
#pragma unroll
            for (int b = 0; b < 2; ++b)
#pragma unroll
                for (int m = 0; m < 4; ++m)
#pragma unroll
                    for (int n = 0; n < 2; ++n) acc[a][b][m][n] = (f32x4){0.f, 0.f, 0.f, 0.f};
        cur = nxt; cA = nA; cB = nB; ++ui;
        if constexpr (ALIGN_EPI) { if (wr == 1) PG8_BAR; }
    }
    PG8_WAIT_V(0);
    if constexpr (!ALIGN_EPI) { if (wr == 0) PG8_BAR; }
    PG8_BAR;
    if constexpr (Epi::AFTER_DRAIN) { E.fused(acc, cur, wr, wc, fr, fq, lds, wid, lane); S.done(cur); }
#undef PG8_SA
#undef PG8_SB
#undef PG8_STAGE
#undef PG8_LDA
#undef PG8_LDB
#undef PG8_MMA
#undef PG8_WAIT_V
#undef PG8_WAIT_L
#undef PG8_BAR
#undef PG8_SCHED
}
}
namespace attn {
using bf16 = __hip_bfloat16;
constexpr int   D = 128, NW = 8, QBLK = 32, KVBLK = 64;
constexpr float SCALE = 0.088388347648318440f;
constexpr float THR = 8.f;
constexpr int SDEPTH = 2;
constexpr int LDQ = 1024, LDK = 256, LDO = 1024;
constexpr size_t SHM_V = KVBLK * D * 2, SHM_K = KVBLK * D * 2, SHM_ATTN = 2 * SHM_V + 2 * SHM_K + NW * 64 * 4;
using bf16x8 = __attribute__((ext_vector_type(8))) short;
using s16x4  = __attribute__((ext_vector_type(4))) short;
using f32x16 = __attribute__((ext_vector_type(16))) float;
using f32x8  = __attribute__((ext_vector_type(8))) float;
using u32x4  = __attribute__((ext_vector_type(4))) unsigned;
#define KSWZ(row, colB) ((row) * 256 + ((colB) ^ (((row) & 7) << 4)))
#define SBAR() __builtin_amdgcn_sched_barrier(0)
__device__ __forceinline__ int crow(int r, int hi) { return (r & 3) + 8 * (r >> 2) + 4 * hi; }
__device__ __forceinline__ unsigned cvtpk(float lo, float hi) {
  unsigned r; asm volatile("v_cvt_pk_bf16_f32 %0, %1, %2" : "=v"(r) : "v"(lo), "v"(hi)); return r;
}
template <typename TIn> struct Stage;
template <> struct Stage<bf16>  { using T = bf16x8;
  __device__ static __forceinline__ T ld8(const bf16* p) { return *reinterpret_cast<const bf16x8*>(p); }
  __device__ static __forceinline__ bf16x8 tobf(T x) { return x; } };
template <> struct Stage<float> { using T = f32x8;
  __device__ static __forceinline__ T ld8(const float* p) { return *reinterpret_cast<const f32x8*>(p); }
  __device__ static __forceinline__ bf16x8 tobf(T x) {
    u32x4 w = {cvtpk(x[0], x[1]), cvtpk(x[2], x[3]), cvtpk(x[4], x[5]), cvtpk(x[6], x[7])}; return *reinterpret_cast<bf16x8*>(&w); } };

__device__ __forceinline__ void partialSM(f32x16& p0, f32x16& p1, float& m_reg, float& mn, float& alpha) {
  constexpr float C = SCALE * 1.4426950408889634f;
  float pmax = p0[0]; for (int r = 1; r < 16; ++r) pmax = fmaxf(pmax, p0[r]); for (int r = 0; r < 16; ++r) pmax = fmaxf(pmax, p1[r]);
  { auto rr = __builtin_amdgcn_permlane32_swap(__float_as_uint(pmax), __float_as_uint(pmax), false, false);
    pmax = fmaxf(__uint_as_float(rr[0]), __uint_as_float(rr[1])); }
  if (__builtin_expect(__all(pmax - m_reg <= THR / SCALE), 1)) { mn = m_reg; alpha = 1.f; }
  else { mn = fmaxf(m_reg, pmax); alpha = __builtin_amdgcn_exp2f((m_reg - mn) * C); m_reg = mn; }
  float mnC = -mn * C;
  for (int r = 0; r < 16; ++r) p0[r] = fmaf(p0[r], C, mnC); for (int r = 0; r < 16; ++r) p1[r] = fmaf(p1[r], C, mnC);
  for (int r = 0; r < 16; ++r) p0[r] = __builtin_amdgcn_exp2f(p0[r]);
}
__device__ __forceinline__ void finishSM(f32x16& p0, f32x16& p1, float alpha, float& l_reg, bf16x8& pa0, bf16x8& pa1, bf16x8& pa2, bf16x8& pa3) {
  for (int r = 0; r < 16; ++r) p1[r] = __builtin_amdgcn_exp2f(p1[r]);
  float ps = 0; for (int r = 0; r < 16; ++r) ps += p0[r]; for (int r = 0; r < 16; ++r) ps += p1[r];
  { auto rr = __builtin_amdgcn_permlane32_swap(__float_as_uint(ps), __float_as_uint(ps), false, false);
    ps = __uint_as_float(rr[0]) + __uint_as_float(rr[1]); }
  l_reg = l_reg * alpha + ps;
#define PK4(P, BASE, OUT) do { unsigned a0 = cvtpk(P[BASE + 0], P[BASE + 1]), a1 = cvtpk(P[BASE + 2], P[BASE + 3]);   \
    unsigned b0 = cvtpk(P[BASE + 4], P[BASE + 5]), b1 = cvtpk(P[BASE + 6], P[BASE + 7]);                              \
    auto r0 = __builtin_amdgcn_permlane32_swap(a0, b0, false, false); auto r1 = __builtin_amdgcn_permlane32_swap(a1, b1, false, false); \
    u32x4 w = {r0[0], r1[0], r0[1], r1[1]}; OUT = *reinterpret_cast<bf16x8*>(&w); } while (0)
  PK4(p0, 0, pa0); PK4(p0, 8, pa1); PK4(p1, 0, pa2); PK4(p1, 8, pa3);
#undef PK4
}
__device__ __forceinline__ void qkt(f32x16& p0, f32x16& p1, const bf16* Ks, const bf16x8* qr, int r32, int hi) {
  p0 = f32x16{}; p1 = f32x16{};
  for (int d0 = 0; d0 < 8; ++d0) { int cb = (d0 * 16 + hi * 8) * 2;
    bf16x8 b0 = *reinterpret_cast<const bf16x8*>((const char*)Ks + KSWZ(r32, cb));
    bf16x8 b1 = *reinterpret_cast<const bf16x8*>((const char*)Ks + KSWZ(32 + r32, cb));
    p0 = __builtin_amdgcn_mfma_f32_32x32x16_bf16(b0, qr[d0], p0, 0, 0, 0);
    p1 = __builtin_amdgcn_mfma_f32_32x32x16_bf16(b1, qr[d0], p1, 0, 0, 0); }
}
__device__ __forceinline__ int v_st(int k, int c) { const int kk = (k & ~0xC) | ((k & 4) << 1) | ((k & 8) >> 1); return ((kk >> 3) * 4 + (c >> 5)) * 512 + ((kk & 7) * 32 + (c & 31)) * 2; }
__device__ __forceinline__ int v_rd_base(int lane) { return ((lane & 3) << 3) | (((lane >> 2) & 3) << 6) | (((lane >> 4) & 1) << 5) | (((lane >> 5) & 1) << 8); }
constexpr int v_rd_off(int d0, int ks, int half) { return d0 * 512 + ks * 4096 + half * 2048; }
template <int OFF> __device__ __forceinline__ s16x4 tr_read(int vb) {
  s16x4 r; asm volatile("ds_read_b64_tr_b16 %0, %1 offset:%2" : "=&v"(r) : "v"(vb), "i"(OFF) : "memory"); return r;
}
template <int D0> __device__ __forceinline__ void pv_one(f32x16& od, int vb, bf16x8 pa0, bf16x8 pa1, bf16x8 pa2, bf16x8 pa3) {
  const s16x4 l0 = tr_read<v_rd_off(D0, 0, 0)>(vb), h0 = tr_read<v_rd_off(D0, 0, 1)>(vb), l1 = tr_read<v_rd_off(D0, 1, 0)>(vb), h1 = tr_read<v_rd_off(D0, 1, 1)>(vb);
  const s16x4 l2 = tr_read<v_rd_off(D0, 2, 0)>(vb), h2 = tr_read<v_rd_off(D0, 2, 1)>(vb), l3 = tr_read<v_rd_off(D0, 3, 0)>(vb), h3 = tr_read<v_rd_off(D0, 3, 1)>(vb);
  asm volatile("s_waitcnt lgkmcnt(0)" ::: "memory"); SBAR();
#define PK(L, H) (bf16x8){L[0], L[1], L[2], L[3], H[0], H[1], H[2], H[3]}
  od = __builtin_amdgcn_mfma_f32_32x32x16_bf16(pa0, PK(l0, h0), od, 0, 0, 0);
  od = __builtin_amdgcn_mfma_f32_32x32x16_bf16(pa1, PK(l1, h1), od, 0, 0, 0);
  od = __builtin_amdgcn_mfma_f32_32x32x16_bf16(pa2, PK(l2, h2), od, 0, 0, 0);
  od = __builtin_amdgcn_mfma_f32_32x32x16_bf16(pa3, PK(l3, h3), od, 0, 0, 0);
#undef PK
}
__device__ __forceinline__ void pv_d0(f32x16* o, int vb, bf16x8 pa0, bf16x8 pa1, bf16x8 pa2, bf16x8 pa3) {
  pv_one<0>(o[0], vb, pa0, pa1, pa2, pa3); pv_one<1>(o[1], vb, pa0, pa1, pa2, pa3); pv_one<2>(o[2], vb, pa0, pa1, pa2, pa3); pv_one<3>(o[3], vb, pa0, pa1, pa2, pa3);
}

template <typename TQ>
__device__ __forceinline__ void attn_dense_body(const TQ* __restrict__ Qb, const bf16* __restrict__ Kh, const bf16* __restrict__ Vh,
                                                unsigned short* Ob, int seq, char* lds, const float* __restrict__ qgain, const float* __restrict__ cs_tab, const float* __restrict__ sn_tab) {
  using St = Stage<bf16>; using SQ = Stage<TQ>;
  int tid_ = threadIdx.x; asm volatile("" : "+v"(tid_));
  const int tid = tid_, wid = tid >> 6, lane = tid & 63, r32 = lane & 31, hi = lane >> 5;
  bf16* V_lds = (bf16*)lds; bf16* K_lds = (bf16*)(lds + 2 * SHM_V);
  float* ws = (float*)(lds + 2 * SHM_V + 2 * SHM_K) + wid * 64; float* li_l = ws; float* al_l = ws + 32;
  float m_reg = -1e30f, l_reg = 0; f32x16 o[4] = {}; bf16x8 qr[8];
  const TQ* Qw = Qb + (long)(wid * QBLK + r32) * LDQ + hi * 8;
  { float xq[8][8]; float ss = 0.f;
#pragma unroll
    for (int d0 = 0; d0 < 8; ++d0) { const u32x4 w = *reinterpret_cast<const u32x4*>(Qw + d0 * 16);
#pragma unroll
      for (int e2 = 0; e2 < 4; ++e2) { xq[d0][2 * e2] = __uint_as_float(w[e2] << 16); xq[d0][2 * e2 + 1] = __uint_as_float(w[e2] & 0xffff0000u); }
#pragma unroll
      for (int e = 0; e < 8; ++e) ss += xq[d0][e] * xq[d0][e]; }
    ss += __shfl_xor(ss, 32);
    const float rn = 1.f / sqrtf(ss * (1.f / 128.f) + 1e-6f);
#pragma unroll
    for (int d0 = 0; d0 < 8; ++d0) { const f32x8 g8 = *reinterpret_cast<const f32x8*>(qgain + d0 * 16 + hi * 8);
#pragma unroll
      for (int e = 0; e < 8; ++e) xq[d0][e] *= rn * g8[e]; }
    if (cs_tab) {
      const long trow = (long)(wid * QBLK + r32) * 64;
#pragma unroll
      for (int ax = 0; ax < 2; ++ax)
#pragma unroll
        for (int lo = 0; lo < 2; ++lo) { const int d1 = 4 * ax + lo, d2 = d1 + 2, p0 = lo * 16 + hi * 8;
          const f32x8 c8 = *reinterpret_cast<const f32x8*>(cs_tab + trow + ax * 32 + p0), s8 = *reinterpret_cast<const f32x8*>(sn_tab + trow + ax * 32 + p0);
#pragma unroll
          for (int e = 0; e < 8; ++e) { const float x1 = xq[d1][e], x2 = xq[d2][e]; xq[d1][e] = x1 * c8[e] - x2 * s8[e]; xq[d2][e] = x2 * c8[e] + x1 * s8[e]; } }
    }
#pragma unroll
    for (int d0 = 0; d0 < 8; ++d0) { u32x4 w = {cvtpk(xq[d0][0], xq[d0][1]), cvtpk(xq[d0][2], xq[d0][3]), cvtpk(xq[d0][4], xq[d0][5]), cvtpk(xq[d0][6], xq[d0][7])}; qr[d0] = *reinterpret_cast<bf16x8*>(&w); }
  }
  const int sr = tid >> 4, sc = (tid & 15) * 8, vst0 = v_st(sr, sc), vst1 = v_st(32 + sr, sc);
  const int vb0 = (int)(uintptr_t)V_lds + v_rd_base(lane);
  struct { typename St::T vs0, vs1, ks0, ks1; } sr_[SDEPTH];
  const int goff0 = sr * LDK + sc, goff1 = (32 + sr) * LDK + sc;
#define SLOAD(i, k0) do { const bf16* vb_ = Vh + (long)(k0) * LDK; const bf16* kb_ = Kh + (long)(k0) * LDK; \
    sr_[i].vs0 = St::ld8(vb_ + goff0); sr_[i].vs1 = St::ld8(vb_ + goff1); sr_[i].ks0 = St::ld8(kb_ + goff0); sr_[i].ks1 = St::ld8(kb_ + goff1); } while (0)
#define SWRITE(b, i) do { *(bf16x8*)((char*)V_lds + (b) * SHM_V + vst0) = St::tobf(sr_[i].vs0);          \
    *(bf16x8*)((char*)V_lds + (b) * SHM_V + vst1) = St::tobf(sr_[i].vs1); int kc = sc * 2;               \
    *(bf16x8*)((char*)K_lds + (b) * SHM_K + KSWZ(sr, kc)) = St::tobf(sr_[i].ks0);                       \
    *(bf16x8*)((char*)K_lds + (b) * SHM_K + KSWZ(32 + sr, kc)) = St::tobf(sr_[i].ks1); } while (0)
#define SWAIT() do { if constexpr (SDEPTH == 2) asm volatile("s_waitcnt vmcnt(4)" ::: "memory"); else asm volatile("s_waitcnt vmcnt(0)" ::: "memory"); } while (0)
#define RESC(a) do { if (__any((a) < 1.f)) { if (hi == 0) al_l[r32] = (a); asm volatile("s_waitcnt lgkmcnt(0)" ::: "memory"); \
    for (int d = 0; d < 4; ++d) for (int r = 0; r < 16; ++r) o[d][r] *= al_l[crow(r, hi)]; } } while (0)
  f32x16 pA0, pA1, pB0, pB1; float mnA, mnB, alA, alB; bf16x8 pa0, pa1, pa2, pa3; const int NT = seq / KVBLK;
  constexpr int SE = 0, SO = SDEPTH - 1;
  SLOAD(SE, 0); asm volatile("s_waitcnt vmcnt(0)" ::: "memory"); SWRITE(0, SE); __syncthreads();
  qkt(pA0, pA1, K_lds, qr, r32, hi); partialSM(pA0, pA1, m_reg, mnA, alA);
  SLOAD(SO, KVBLK); if constexpr (SDEPTH == 2) { if (2 < NT) SLOAD(SE, 2 * KVBLK); }
  SWAIT(); SWRITE(1, SO); __syncthreads();
  for (int j = 1; j + 1 < NT; j += 2) {
    SBAR(); qkt(pB0, pB1, (bf16*)((char*)K_lds + SHM_K), qr, r32, hi);
    finishSM(pA0, pA1, alA, l_reg, pa0, pa1, pa2, pa3); SBAR();
    SLOAD(SO, (j + SDEPTH) * KVBLK); SBAR();
    pv_d0(o, vb0, pa0, pa1, pa2, pa3); partialSM(pB0, pB1, m_reg, mnB, alB);
    __syncthreads(); SWAIT(); SWRITE(0, SE);
    RESC(alB); __syncthreads();
    SBAR(); qkt(pA0, pA1, K_lds, qr, r32, hi);
    finishSM(pB0, pB1, alB, l_reg, pa0, pa1, pa2, pa3); SBAR();
    if (SDEPTH == 1 || j + 3 < NT) SLOAD(SE, (j + 1 + SDEPTH) * KVBLK); SBAR();
    pv_d0(o, vb0 + (int)SHM_V, pa0, pa1, pa2, pa3); partialSM(pA0, pA1, m_reg, mnA, alA);
    __syncthreads(); SWAIT(); SWRITE(1, SO);
    RESC(alA); __syncthreads();
  }
  SBAR(); qkt(pB0, pB1, (bf16*)((char*)K_lds + SHM_K), qr, r32, hi);
  finishSM(pA0, pA1, alA, l_reg, pa0, pa1, pa2, pa3); SBAR();
  pv_d0(o, vb0, pa0, pa1, pa2, pa3); partialSM(pB0, pB1, m_reg, mnB, alB);
  __syncthreads(); RESC(alB);
  finishSM(pB0, pB1, alB, l_reg, pa0, pa1, pa2, pa3); SBAR();
  pv_d0(o, vb0 + (int)SHM_V, pa0, pa1, pa2, pa3);
  if (hi == 0) li_l[r32] = l_reg; asm volatile("s_waitcnt lgkmcnt(0)" ::: "memory");
  float rli[16];
#pragma unroll
  for (int r = 0; r < 16; ++r) rli[r] = __builtin_amdgcn_rcpf(li_l[crow(r, hi)]);
  unsigned short* Ow = Ob + (long)(wid * QBLK) * LDO;
#pragma unroll
  for (int r = 0; r < 16; ++r) { int orow = crow(r, hi);
    for (int d0 = 0; d0 < 4; ++d0) Ow[(long)orow * LDO + d0 * 32 + r32] = (unsigned short)(cvtpk(o[d0][r] * rli[r], 0.f) & 0xffffu); }
#undef SLOAD
#undef SWRITE
#undef SWAIT
#undef RESC
}
#undef KSWZ
#undef SBAR
}
#define GAS __attribute__((address_space(1)))
#define LAS __attribute__((address_space(3)))
typedef unsigned short bf16_t;
typedef unsigned v4u __attribute__((ext_vector_type(4)));
typedef unsigned v2u __attribute__((ext_vector_type(2)));
typedef float f32x4 __attribute__((ext_vector_type(4)));
typedef float f32x16 __attribute__((ext_vector_type(16)));
typedef short bf16x8 __attribute__((ext_vector_type(8)));
typedef short bf16x4 __attribute__((ext_vector_type(4)));

constexpr int DM = 1024, NB = 32, SEQ = 2048, CTXL = 256;
constexpr int ML = NB * SEQ, MC = NB * CTXL, MT = ML + MC;
constexpr int DFF = 2816, NFF1 = 2 * DFF;
constexpr int NMODC = 9 * DM;
constexpr int KVS = SEQ + CTXL;
constexpr int NQKV = 1536, NMLIN = 3088, NMLPAD = 3328, PLD = 3072;
constexpr float ALPHA = 1.41421356237309515f;
constexpr float LN_EPS = 1e-5f, RMS_EPS = 1e-6f;
constexpr int NWAVES = 8, NTHR = 512;
constexpr int LDS_BYTES = 132096;

constexpr size_t MiB = 1u << 20;
constexpr size_t WS_CTL = 0;
constexpr size_t WS_STATS = 1 * MiB;
constexpr size_t WS_W1 = 4 * MiB;
constexpr size_t W1_SZ = (size_t)NFF1 * DM * 2;
constexpr size_t WS_W2 = WS_W1 + 4 * W1_SZ;
constexpr size_t W2_SZ = (size_t)DM * DFF * 2;
constexpr size_t WS_WQKV = WS_W2 + 4 * W2_SZ;
constexpr size_t WS_WOA = WS_WQKV + (size_t)NQKV * DM * 2;
constexpr size_t WS_WMI = WS_WOA + (size_t)DM * DM * 2;
constexpr size_t WS_WMO = WS_WMI + (size_t)NMLPAD * DM * 2;
constexpr size_t WS_WEND = WS_WMO + (size_t)DM * DM * 2;
static_assert(WS_WEND <= 92 * MiB, "weights");
constexpr size_t WS_MOD = 92 * MiB;
constexpr size_t WS_ROPE = 95 * MiB;
constexpr size_t WS_H = 96 * MiB;
constexpr size_t WS_XM = 384 * MiB;
constexpr size_t WS_BIG = 528 * MiB;
constexpr size_t WS_Q = WS_BIG, WS_K = WS_BIG + 144 * MiB, WS_V = WS_K + 36 * MiB;
constexpr size_t WS_G = 960 * MiB;
constexpr size_t WS_END = 966 * MiB;

using attn::cvtpk;
__device__ __forceinline__ float bflo(unsigned w) { return __uint_as_float(w << 16); }
__device__ __forceinline__ float bfhi(unsigned w) { return __uint_as_float(w & 0xffff0000u); }
__device__ __forceinline__ float siluf(float a) { return a * __builtin_amdgcn_rcpf(1.f + __expf(-a)); }
__device__ __forceinline__ float wave_sum(float v) {
#pragma unroll
    for (int o = 1; o < 64; o <<= 1) v += __shfl_xor(v, o);
    return v;
}
#define LDS_WAIT() asm volatile("s_waitcnt lgkmcnt(0)" ::: "memory")

struct EpiSwiglu {
    static constexpr bool PERM = true, AFTER_DRAIN = false;
    bf16_t* O;
    __device__ __forceinline__ void operator()(const pg8::f32x4 (&acc)[2][2][4][2], const pg8::Unit& u, int wr, int wc, int fr, int fq) const {
        const int row0 = u.pm * 256 + wr * 64 + fr, col0 = u.pn * 128 + wc * 32 + 8 * fq;
#pragma unroll
        for (int ai = 0; ai < 2; ++ai)
#pragma unroll
            for (int m = 0; m < 4; ++m) {
                bf16_t* rowp = O + (size_t)(row0 + ai * 128 + m * 16) * DFF + col0;
                const pg8::f32x4 a0 = acc[ai][0][m][0], a1 = acc[ai][0][m][1], u0 = acc[ai][1][m][0], u1 = acc[ai][1][m][1];
                v4u w;
                w.x = cvtpk(siluf(a0[0]) * u0[0], siluf(a0[1]) * u0[1]); w.y = cvtpk(siluf(a0[2]) * u0[2], siluf(a0[3]) * u0[3]);
                w.z = cvtpk(siluf(a1[0]) * u1[0], siluf(a1[1]) * u1[1]); w.w = cvtpk(siluf(a1[2]) * u1[2], siluf(a1[3]) * u1[3]);
                *(v4u*)rowp = w;
            }
    }
};
typedef _Float16 h16x8 __attribute__((ext_vector_type(8)));
template <bool LNRES, int GS2> struct EpiResid {
    static constexpr bool PERM = true, AFTER_DRAIN = false;
    const float* res_lat; const float* res_ctx; _Float16* Z; const float* gate; const float* stats; const float* lg; const float* lb;
    __device__ __forceinline__ void operator()(const pg8::f32x4 (&acc)[2][2][4][2], const pg8::Unit& u, int wr, int wc, int fr, int fq) const {
        const int r0 = u.pm * 256, row0 = r0 + wr * 64 + fr;
        const int bi = r0 < ML ? (r0 >> 11) : NB;
#pragma unroll
        for (int bj = 0; bj < 2; ++bj) {
            const int c = u.pn * 256 + bj * 128 + wc * 32 + 8 * fq;
            const pg8::f32x4 gv0 = *(const pg8::f32x4*)(gate + (size_t)bi * NMODC + c) * (0.5f * GS2), gv1 = *(const pg8::f32x4*)(gate + (size_t)bi * NMODC + c + 4) * (0.5f * GS2);
            pg8::f32x4 g0 = {1.f, 1.f, 1.f, 1.f}, g1 = g0, b0 = {0.f, 0.f, 0.f, 0.f}, b1 = b0;
            if (LNRES) { g0 = *(const pg8::f32x4*)(lg + c); g1 = *(const pg8::f32x4*)(lg + c + 4); b0 = *(const pg8::f32x4*)(lb + c); b1 = *(const pg8::f32x4*)(lb + c + 4); }
#pragma unroll
            for (int ai = 0; ai < 2; ++ai)
#pragma unroll
                for (int m = 0; m < 4; ++m) {
                    const int row = row0 + ai * 128 + m * 16;
                    pg8::f32x4 ra, rb;
                    if (LNRES) { const h16x8 zz = *(const h16x8*)(Z + (size_t)row * DM + c); const float mean = stats[2 * row], rstd = stats[2 * row + 1];
                        ra = (pg8::f32x4){(float)zz[0], (float)zz[1], (float)zz[2], (float)zz[3]}; rb = (pg8::f32x4){(float)zz[4], (float)zz[5], (float)zz[6], (float)zz[7]};
                        ra = (ra - mean) * rstd * g0 + b0; rb = (rb - mean) * rstd * g1 + b1; }
                    else { const float* rp = (row < ML ? res_lat + (size_t)row * DM : res_ctx + (size_t)(row - ML) * DM) + c; ra = *(const pg8::f32x4*)rp; rb = *(const pg8::f32x4*)(rp + 4); }
                    const pg8::f32x4 oa = ra * ALPHA + gv0 * acc[ai][bj][m][0], ob = rb * ALPHA + gv1 * acc[ai][bj][m][1];
                    h16x8 o; o[0] = (_Float16)oa[0]; o[1] = (_Float16)oa[1]; o[2] = (_Float16)oa[2]; o[3] = (_Float16)oa[3]; o[4] = (_Float16)ob[0]; o[5] = (_Float16)ob[1]; o[6] = (_Float16)ob[2]; o[7] = (_Float16)ob[3];
                    *(h16x8*)(Z + (size_t)row * DM + c) = o;
                }
        }
    }
};
struct EpiQKV {
    static constexpr bool PERM = true, AFTER_DRAIN = false;
    bf16_t* Q; bf16_t* Kb; bf16_t* Vb;
    __device__ __forceinline__ void operator()(const pg8::f32x4 (&acc)[2][2][4][2], const pg8::Unit& u, int wr, int wc, int fr, int fq) const {
        const int r0 = u.pm * 256; bf16_t* base; int ld;
        if (u.pn < 4) { base = Q + (size_t)r0 * DM + u.pn * 256; ld = DM; }
        else { const int kvr = r0 < ML ? (r0 >> 11) * KVS + (r0 & 2047) : ((r0 - ML) >> 8) * KVS + SEQ + ((r0 - ML) & 255);
               base = (u.pn == 4 ? Kb : Vb) + (size_t)kvr * 256; ld = 256; }
        const int rl = wr * 64 + fr, col0 = wc * 32 + 8 * fq;
#pragma unroll
        for (int ai = 0; ai < 2; ++ai)
#pragma unroll
            for (int m = 0; m < 4; ++m) {
                bf16_t* rowp = base + (size_t)(rl + ai * 128 + m * 16) * ld + col0;
#pragma unroll
                for (int bj = 0; bj < 2; ++bj) { const pg8::f32x4 v0 = acc[ai][bj][m][0], v1 = acc[ai][bj][m][1];
                    v4u w; w.x = cvtpk(v0[0], v0[1]); w.y = cvtpk(v0[2], v0[3]); w.z = cvtpk(v1[0], v1[1]); w.w = cvtpk(v1[2], v1[3]);
                    *(v4u*)(rowp + bj * 128) = w; }
            }
    }
};
struct EpiMlIn {
    static constexpr bool PERM = true, AFTER_DRAIN = false;
    bf16_t* P; float* G; const float* gate_b;
    __device__ __forceinline__ void operator()(const pg8::f32x4 (&acc)[2][2][4][2], const pg8::Unit& u, int wr, int wc, int fr, int fq) const {
        const int row0 = u.pm * 256 + wr * 64 + fr;
        if (u.pn < 12) {
            const int col0 = u.pn * 256 + wc * 32 + 8 * fq;
#pragma unroll
            for (int ai = 0; ai < 2; ++ai)
#pragma unroll
                for (int m = 0; m < 4; ++m) {
                    bf16_t* rowp = P + (size_t)(row0 + ai * 128 + m * 16) * PLD + col0;
#pragma unroll
                    for (int bj = 0; bj < 2; ++bj) { const pg8::f32x4 v0 = acc[ai][bj][m][0], v1 = acc[ai][bj][m][1];
                        v4u w; w.x = cvtpk(v0[0], v0[1]); w.y = cvtpk(v0[2], v0[3]); w.z = cvtpk(v1[0], v1[1]); w.w = cvtpk(v1[2], v1[3]);
                        *(v4u*)(rowp + bj * 128) = w; }
                }
        } else if (wc == 0 && fq < 2) {
            const pg8::f32x4 b0 = *(const pg8::f32x4*)(gate_b + 8 * fq), b1 = *(const pg8::f32x4*)(gate_b + 8 * fq + 4);
#pragma unroll
            for (int ai = 0; ai < 2; ++ai)
#pragma unroll
                for (int m = 0; m < 4; ++m) {
                    float* gp = G + (size_t)(row0 + ai * 128 + m * 16) * 16 + 8 * fq;
                    *(pg8::f32x4*)gp = acc[ai][0][m][0] + b0; *(pg8::f32x4*)(gp + 4) = acc[ai][0][m][1] + b1;
                }
        }
    }
};

typedef GAS unsigned gu32;
constexpr int XB_LDS_OFF = 131072;
#define XB_TMO      128
#define XB_XCNT(j)  (256  + 64 * (j))
#define XB_XSUB(j)  (1280 + 64 * (j))
#define XB_XGEN(j)  (2304 + 64 * (j))
#define XB_TOP      3328
#define XB_TOPGEN   3392
#define XCD_BAR_WORDS 3456
#define XB_SPIN_CAP (1u << 18)

__device__ __forceinline__ unsigned xb_ld(unsigned* p)              { return __hip_atomic_load(p, __ATOMIC_RELAXED, __HIP_MEMORY_SCOPE_AGENT); }
__device__ __forceinline__ unsigned xb_add(unsigned* p, unsigned v) { return __hip_atomic_fetch_add(p, v, __ATOMIC_RELAXED, __HIP_MEMORY_SCOPE_AGENT); }
__device__ __forceinline__ unsigned xb_xcc_id() { return (unsigned)__builtin_amdgcn_s_getreg((3 << 11) | 20) & 0xFu; }
#define XB_SPIN(cond, bar) do { unsigned _sp = 0; while (cond) { __builtin_amdgcn_s_sleep(1); \
    if ((++_sp & 255u) == 0u) { if (xb_ld(&(bar)[XB_TMO])) break; if (_sp > XB_SPIN_CAP) { atomicAdd(&(bar)[XB_TMO], 1u); break; } } } } while (0)

struct XcdBarrier {
    unsigned* bar; unsigned x;
    volatile LAS unsigned* st;
};

__device__ __forceinline__ XcdBarrier xcd_barrier_post(unsigned* bar, volatile LAS unsigned* st) {
    XcdBarrier b; b.bar = bar; b.x = xb_xcc_id(); b.st = st;
    if (threadIdx.x == 0) (void)xb_add(&bar[XB_XCNT(b.x)], 1u);
    return b;
}
__device__ __forceinline__ void xcd_barrier_complete(unsigned* bar, unsigned x, unsigned& nloc, unsigned& nx) {
    const unsigned G = gridDim.x * gridDim.y * gridDim.z;
    unsigned sum, cnt, mine, sp = 0u;
    for (;;) {
        sum = 0u; cnt = 0u; mine = 0u;
#pragma unroll
        for (unsigned j = 0; j < 16; ++j) { const unsigned c = xb_ld(&bar[XB_XCNT(j)]); sum += c; cnt += (c > 0u) ? 1u : 0u; mine = (j == x) ? c : mine; }
        if (sum == G) break;
        __builtin_amdgcn_s_sleep(1);
        if ((++sp & 255u) == 0u) { if (xb_ld(&bar[XB_TMO])) break; if (sp > XB_SPIN_CAP) { atomicAdd(&bar[XB_TMO], 1u); break; } }
    }
    nloc = mine > 0u ? mine : 1u; nx = cnt > 0u ? cnt : 1u;
}

__device__ __forceinline__ void xcd_barrier(const XcdBarrier& b) {
    asm volatile("s_waitcnt vmcnt(0)" ::: "memory");
    __syncthreads();
    if (threadIdx.x == 0) {
        unsigned* bar = b.bar;
        __builtin_amdgcn_s_waitcnt(0);
        unsigned nloc = b.st[0], nx = b.st[1];
        if (nloc == 0u) { xcd_barrier_complete(bar, b.x, nloc, nx); b.st[0] = nloc; b.st[1] = nx; }
        const unsigned old = xb_add(&bar[XB_XSUB(b.x)], 1u);
        const unsigned gen = old / nloc;
        if (old + 1u == (gen + 1u) * nloc) {
            __builtin_amdgcn_fence(__ATOMIC_RELEASE, "agent");
            asm volatile("s_waitcnt vmcnt(0)" ::: "memory");
            const unsigned og = xb_add(&bar[XB_TOP], 1u);
            const unsigned tg = og / nx;
            if (og + 1u == (tg + 1u) * nx) xb_add(&bar[XB_TOPGEN], 1u);
            else XB_SPIN(xb_ld(&bar[XB_TOPGEN]) == tg, bar);
            __builtin_amdgcn_fence(__ATOMIC_ACQUIRE, "agent");
            xb_add(&bar[XB_XGEN(b.x)], 1u);
            asm volatile("s_waitcnt vmcnt(0)" ::: "memory");
        } else {
            XB_SPIN(xb_ld(&bar[XB_XGEN(b.x)]) == gen, bar);
            __builtin_amdgcn_fence(__ATOMIC_ACQUIRE, "agent");
            asm volatile("s_waitcnt vmcnt(0)" ::: "memory");
        }
    }
    __syncthreads();
}


struct Args { const float* in[20]; float* out; unsigned char* ws; int ph_lo, ph_hi; };
struct Ctx {
    LAS unsigned char* lds; char* ldsg;
    int tid, lane, wave, G, bid;
    float* out; unsigned char* ws;
};
__device__ __forceinline__ unsigned long long karg_u64(int byte_off) {
    unsigned long long base = (unsigned long long)__builtin_amdgcn_kernarg_segment_ptr(); asm volatile("" : "+s"(base));
    return *(const __attribute__((address_space(4))) unsigned long long*)(base + byte_off);
}
#define ARG_IN(i) ((const float*)(const GAS float*)karg_u64(8 * (i)))
__device__ __forceinline__ void relane(Ctx& F) {
    int t_ = threadIdx.x; asm volatile("" : "+v"(t_)); F.tid = t_; F.lane = t_ & 63; F.wave = __builtin_amdgcn_readfirstlane(t_ >> 6);
    int b_ = blockIdx.x, g_ = gridDim.x; asm volatile("" : "+s"(b_), "+s"(g_)); F.bid = b_; F.G = g_;
    F.out = (float*)(GAS float*)karg_u64(160); F.ws = (unsigned char*)(GAS unsigned char*)karg_u64(168);
}
__device__ __forceinline__ void transpose_item(const float* __restrict__ W, int K, int N, bf16_t* WT, int k0, int n0, int drow0, LAS float* scr, int lane) {
    const int nq = (lane & 7) * 4, kr = lane >> 3;
    const bool ok = n0 + nq < N;
    f32x4 t[8];
#pragma unroll
    for (int i = 0; i < 8; ++i) t[i] = ok ? *(const f32x4*)(W + (size_t)(k0 + 8 * i + kr) * N + n0 + nq) : (f32x4){0.f, 0.f, 0.f, 0.f};
#pragma unroll
    for (int i = 0; i < 8; ++i) { LAS float* d = scr + (8 * i + kr) * 33 + nq; d[0] = t[i][0]; d[1] = t[i][1]; d[2] = t[i][2]; d[3] = t[i][3]; }
    LDS_WAIT(); asm volatile("" ::: "memory");
    const int c = lane & 7;
#pragma unroll
    for (int j = 0; j < 4; ++j) { const int n = (lane >> 3) + 8 * j; const LAS float* s = scr + (8 * c) * 33 + n;
        v4u o; o.x = cvtpk(s[0 * 33], s[1 * 33]); o.y = cvtpk(s[2 * 33], s[3 * 33]); o.z = cvtpk(s[4 * 33], s[5 * 33]); o.w = cvtpk(s[6 * 33], s[7 * 33]);
        *(v4u*)(WT + (size_t)(drow0 + n) * K + k0 + 8 * c) = o; }
    LDS_WAIT(); asm volatile("" ::: "memory");
}
__device__ __forceinline__ void p0_weights(Ctx& F, const float* w_ffn_in, const float* w_ffn_out, const float* w_att_in, const float* w_att_out, const float* w_ml_in, const float* w_ml_out) {
    LAS float* scr = (LAS float*)(F.lds + F.wave * 8448);
    const int nlight = F.G >= 64 ? 32 : 0;
    const int gw = F.bid < nlight ? (F.wave < 4 ? F.bid * 4 + F.wave : -1) : nlight * 4 + (F.bid - nlight) * NWAVES + F.wave, NGW = nlight * 4 + (F.G - nlight) * NWAVES;
    constexpr int I_W1 = 16 * (NFF1 / 32), I_W2 = (DFF / 64) * (DM / 32), I_QKV = 16 * (NQKV / 32), I_O = 16 * 32, I_MI = 16 * (NMLPAD / 32);
    constexpr int NITEMS = 4 * I_W1 + 4 * I_W2 + I_QKV + I_O + I_MI + I_O;
    for (int it = gw < 0 ? NITEMS : gw; it < NITEMS; it += NGW) {
        int r = it; const float* src; bf16_t* dst; int K, N, nblk, mode = 0;
        if (r < 4 * I_W1) { const int mi = r / I_W1; r -= mi * I_W1; src = w_ffn_in + (size_t)mi * DM * NFF1; dst = (bf16_t*)(F.ws + WS_W1 + mi * W1_SZ); K = DM; N = NFF1; nblk = NFF1 / 32; mode = 1; }
        else if ((r -= 4 * I_W1) < 4 * I_W2) { const int mi = r / I_W2; r -= mi * I_W2; src = w_ffn_out + (size_t)mi * DFF * DM; dst = (bf16_t*)(F.ws + WS_W2 + mi * W2_SZ); K = DFF; N = DM; nblk = DM / 32; }
        else if ((r -= 4 * I_W2) < I_QKV) { src = w_att_in; dst = (bf16_t*)(F.ws + WS_WQKV); K = DM; N = NQKV; nblk = NQKV / 32; }
        else if ((r -= I_QKV) < I_O) { src = w_att_out; dst = (bf16_t*)(F.ws + WS_WOA); K = DM; N = DM; nblk = DM / 32; }
        else if ((r -= I_O) < I_MI) { src = w_ml_in; dst = (bf16_t*)(F.ws + WS_WMI); K = DM; N = NMLIN; nblk = NMLPAD / 32; }
        else { r -= I_MI; src = w_ml_out; dst = (bf16_t*)(F.ws + WS_WMO); K = DM; N = DM; nblk = DM / 32; }
        const int kb = r / nblk, nb = r - kb * nblk, n0 = 32 * nb;
        int drow = n0;
        if (mode == 1) { const int j0 = n0 < DFF ? n0 : n0 - DFF; drow = 256 * (j0 >> 7) + (j0 & 127) + (n0 < DFF ? 0 : 128); }
        transpose_item(src, K, N, dst, 64 * kb, n0, drow, scr, F.lane);
    }
}
__device__ __forceinline__ void p0_mods(Ctx& F, const float* c, const float* cctx, const float* ada_w, const float* ada_b) {
    float* MOD = (float*)(F.ws + WS_MOD);
    LAS float* sv = (LAS float*)(F.lds + 0) + F.wave * (33 * 32);
    LAS float* red = (LAS float*)(F.lds + 8 * 33 * 32 * 4);
    for (int task = F.bid; task < 2 * (NMODC / 64); task += F.G) {
        const int l = task / (NMODC / 64), n0 = (task % (NMODC / 64)) * 64;
        const float* Wl = ada_w + (size_t)l * DM * NMODC + n0 + F.lane;
        float acc[33];
#pragma unroll
        for (int b = 0; b < 33; ++b) acc[b] = 0.f;
        for (int sub = 0; sub < 4; ++sub) {
            const int k0 = F.wave * 128 + sub * 32;
            for (int idx = F.lane; idx < 33 * 32; idx += 64) { const int b = idx >> 5, kk = idx & 31; const float cv = b < 32 ? c[b * DM + k0 + kk] : cctx[k0 + kk];
                sv[idx] = cv / (1.f + expf(-cv)); }
            LDS_WAIT(); asm volatile("" ::: "memory");
            float n0_ = Wl[(size_t)(k0 + 0) * NMODC], n1_ = Wl[(size_t)(k0 + 1) * NMODC], n2_ = Wl[(size_t)(k0 + 2) * NMODC], n3_ = Wl[(size_t)(k0 + 3) * NMODC];
#pragma unroll 1
            for (int k4 = 0; k4 < 8; ++k4) {
                const float w0 = n0_, w1 = n1_, w2 = n2_, w3 = n3_;
                const int kn = k0 + (k4 < 7 ? 4 * k4 + 4 : 0);
                n0_ = Wl[(size_t)(kn + 0) * NMODC]; n1_ = Wl[(size_t)(kn + 1) * NMODC]; n2_ = Wl[(size_t)(kn + 2) * NMODC]; n3_ = Wl[(size_t)(kn + 3) * NMODC];
#pragma unroll
                for (int b = 0; b < 33; ++b) { const f32x4 s4 = *(const LAS f32x4*)(sv + b * 32 + 4 * k4); acc[b] += s4[0] * w0 + s4[1] * w1 + s4[2] * w2 + s4[3] * w3; }
            }
            LDS_WAIT(); asm volatile("" ::: "memory");
        }
#pragma unroll
        for (int b = 0; b < 33; ++b) red[(F.wave * 33 + b) * 64 + F.lane] = acc[b];
        __syncthreads();
        for (int o = F.tid; o < 33 * 64; o += NTHR) { const int b = o >> 6, n = o & 63; float s = ada_b[l * NMODC + n0 + n];
#pragma unroll
            for (int w = 0; w < 8; ++w) s += red[(w * 33 + b) * 64 + n];
            MOD[((size_t)l * 33 + b) * NMODC + n0 + n] = s; }
        __syncthreads();
    }
}
__device__ __forceinline__ void p0_rope(Ctx& F) {
    float* CS = (float*)(F.ws + WS_ROPE); float* SN = CS + SEQ * 64;
    for (int i = F.bid * NTHR + F.tid; i < SEQ * 64; i += F.G * NTHR) {
        const int t = i >> 6, ax = (i >> 5) & 1, p = i & 31;
        const float pos = (float)(ax == 0 ? (t >> 6) : (t & 63));
        const float inv = powf(10000.0f, -(float)p / 32.0f);
        const float ang = pos * inv;
        CS[i] = cosf(ang); SN[i] = sinf(ang);
    }
}
template <int MODE>
__device__ __forceinline__ void row_pass(Ctx& F, const float* xin, const float* ctxin, int rbeg, int M, int vbid, int vG, const float* g, const float* bta, const float* MODl, int shift_idx, int scale_idx) {
    constexpr int RP = 4;
    const _Float16* Z = (const _Float16*)(F.ws + WS_H); bf16_t* XM = (bf16_t*)(F.ws + WS_XM);
    const int gw = vbid * NWAVES + F.wave, NGW = vG * NWAVES;
    for (int row0 = rbeg + gw * RP; row0 < M; row0 += NGW * RP) {
        float v[RP][2][8];
#pragma unroll
        for (int r = 0; r < RP; ++r) { const int row = row0 + r;
#pragma unroll
            for (int j = 0; j < 2; ++j) { const int col = 8 * F.lane + 512 * j;
                if (MODE == 0) { const float* src = (row < ML ? xin + (size_t)row * DM : ctxin + (size_t)(row - ML) * DM) + col; const f32x4 a = *(const f32x4*)src, b = *(const f32x4*)(src + 4);
#pragma unroll
                    for (int e = 0; e < 4; ++e) { v[r][j][e] = a[e]; v[r][j][4 + e] = b[e]; } }
                else { const h16x8 zz = *(const h16x8*)(Z + (size_t)row * DM + col);
#pragma unroll
                    for (int e = 0; e < 8; ++e) v[r][j][e] = (float)zz[e]; } } }
        if (MODE != 0) {
            float s[RP], s2[RP], mean[RP], rstd[RP];
#pragma unroll
            for (int r = 0; r < RP; ++r) { s[r] = 0.f;
#pragma unroll
                for (int j = 0; j < 2; ++j)
#pragma unroll
                    for (int e = 0; e < 8; ++e) s[r] += v[r][j][e]; }
#pragma unroll
            for (int o = 1; o < 64; o <<= 1) {
#pragma unroll
                for (int r = 0; r < RP; ++r) s[r] += __shfl_xor(s[r], o); }
#pragma unroll
            for (int r = 0; r < RP; ++r) { mean[r] = s[r] * (1.f / DM); s2[r] = 0.f;
#pragma unroll
                for (int j = 0; j < 2; ++j)
#pragma unroll
                    for (int e = 0; e < 8; ++e) { v[r][j][e] -= mean[r]; s2[r] += v[r][j][e] * v[r][j][e]; } }
#pragma unroll
            for (int o = 1; o < 64; o <<= 1) {
#pragma unroll
                for (int r = 0; r < RP; ++r) s2[r] += __shfl_xor(s2[r], o); }
#pragma unroll
            for (int r = 0; r < RP; ++r) { rstd[r] = 1.f / sqrtf(s2[r] * (1.f / DM) + LN_EPS);
                if (MODE == 1 && F.lane == 0) { float* st = (float*)(F.ws + WS_STATS) + 2 * (size_t)(row0 + r); st[0] = mean[r]; st[1] = rstd[r]; } }
#pragma unroll
            for (int j = 0; j < 2; ++j) { const int col = 8 * F.lane + 512 * j; const f32x4 ga = *(const f32x4*)(g + col), gb = *(const f32x4*)(g + col + 4), ba = *(const f32x4*)(bta + col), bb = *(const f32x4*)(bta + col + 4);
#pragma unroll
                for (int r = 0; r < RP; ++r)
#pragma unroll
                    for (int e = 0; e < 4; ++e) { v[r][j][e] = v[r][j][e] * rstd[r] * ga[e] + ba[e]; v[r][j][4 + e] = v[r][j][4 + e] * rstd[r] * gb[e] + bb[e]; } }
        }
        if (MODE == 2) {
#pragma unroll
            for (int r = 0; r < RP; ++r)
#pragma unroll
                for (int j = 0; j < 2; ++j) { float* o = F.out + (size_t)(row0 + r) * DM + 8 * F.lane + 512 * j;
                    *(f32x4*)o = (f32x4){v[r][j][0], v[r][j][1], v[r][j][2], v[r][j][3]}; *(f32x4*)(o + 4) = (f32x4){v[r][j][4], v[r][j][5], v[r][j][6], v[r][j][7]}; }
        } else {
            const int bi = row0 < ML ? (row0 >> 11) : NB;
            const float* mb = MODl + (size_t)bi * NMODC;
#pragma unroll
            for (int j = 0; j < 2; ++j) { const int col = 8 * F.lane + 512 * j;
                const f32x4 sha = *(const f32x4*)(mb + shift_idx * DM + col), shb = *(const f32x4*)(mb + shift_idx * DM + col + 4), sca = *(const f32x4*)(mb + scale_idx * DM + col), scb = *(const f32x4*)(mb + scale_idx * DM + col + 4);
#pragma unroll
                for (int r = 0; r < RP; ++r) { float y[8];
#pragma unroll
                    for (int e = 0; e < 4; ++e) { y[e] = v[r][j][e] * (sca[e] + 1.f) + sha[e]; y[4 + e] = v[r][j][4 + e] * (scb[e] + 1.f) + shb[e]; }
                    v4u w; w.x = cvtpk(y[0], y[1]); w.y = cvtpk(y[2], y[3]); w.z = cvtpk(y[4], y[5]); w.w = cvtpk(y[6], y[7]);
                    *(v4u*)(XM + (size_t)(row0 + r) * DM + col) = w; } }
        }
    }
}
__device__ __forceinline__ void qknorm_rope(Ctx& F, const float* qg, const float* kg) {
    bf16_t* Q = (bf16_t*)(F.ws + WS_Q); bf16_t* Kb = (bf16_t*)(F.ws + WS_K);
    const float* CS = (const float*)(F.ws + WS_ROPE); const float* SN = CS + SEQ * 64;
    const int gw = F.bid * NWAVES + F.wave, NGW = F.G * NWAVES;
    const int grp = F.lane >> 4, j = F.lane & 15, half = (j >> 2) & 1;
    float gq[8], gk[8];
#pragma unroll
    for (int e = 0; e < 8; ++e) { gq[e] = qg[8 * j + e]; gk[e] = kg[8 * j + e]; }
    for (int it = gw; it < MT / 4; it += NGW) {
        const int row = it * 4 + grp; const bool lat = row < ML;
        const int kvr = lat ? (row >> 11) * KVS + (row & 2047) : ((row - ML) >> 8) * KVS + SEQ + ((row - ML) & 255);
        float cs[8], sn[8];
        if (lat) { const int t = row & 2047; const float* cp = CS + t * 64 + (j >> 3) * 32 + (j & 3) * 8; const float* sp = SN + t * 64 + (j >> 3) * 32 + (j & 3) * 8;
#pragma unroll
            for (int e = 0; e < 8; ++e) { cs[e] = cp[e]; sn[e] = half ? sp[e] : -sp[e]; } }
        else {
#pragma unroll
            for (int e = 0; e < 8; ++e) { cs[e] = 1.f; sn[e] = 0.f; } }
        v4u win[10];
#pragma unroll
        for (int hh = 8; hh < 10; ++hh) win[hh] = *(const v4u*)(hh < 8 ? Q + (size_t)row * DM + hh * 128 + 8 * j : Kb + (size_t)kvr * 256 + (hh - 8) * 128 + 8 * j);
#pragma unroll
        for (int hh = 8; hh < 10; ++hh) {
            bf16_t* p = hh < 8 ? Q + (size_t)row * DM + hh * 128 + 8 * j : Kb + (size_t)kvr * 256 + (hh - 8) * 128 + 8 * j;
            const v4u w = win[hh];
            float x[8] = {bflo(w.x), bfhi(w.x), bflo(w.y), bfhi(w.y), bflo(w.z), bfhi(w.z), bflo(w.w), bfhi(w.w)};
            float ss = 0.f;
#pragma unroll
            for (int e = 0; e < 8; ++e) ss += x[e] * x[e];
            ss += __shfl_xor(ss, 1); ss += __shfl_xor(ss, 2); ss += __shfl_xor(ss, 4); ss += __shfl_xor(ss, 8);
            const float r = 1.f / sqrtf(ss * (1.f / 128.f) + RMS_EPS);
            float y[8];
#pragma unroll
            for (int e = 0; e < 8; ++e) { y[e] = x[e] * r * (hh < 8 ? gq[e] : gk[e]); }
#pragma unroll
            for (int e = 0; e < 8; ++e) { const float py = __shfl_xor(y[e], 4); x[e] = y[e] * cs[e] + py * sn[e]; }
            v4u o; o.x = cvtpk(x[0], x[1]); o.y = cvtpk(x[2], x[3]); o.z = cvtpk(x[4], x[5]); o.w = cvtpk(x[6], x[7]);
            *(v4u*)p = o;
        }
    }
}
__device__ __forceinline__ void attn_phase(Ctx& F, const float* qg) {
    bf16_t* Q = (bf16_t*)(F.ws + WS_Q); const attn::bf16* Kb = (const attn::bf16*)(F.ws + WS_K); const attn::bf16* Vb = (const attn::bf16*)(F.ws + WS_V);
    for (int uid = F.bid; uid < 2048 + 256; uid += F.G) {
        int row0, kv0, h, seq;
        if (uid < 2048) { const int g = uid & 3, qb = (uid >> 2) & 7, kvh = (uid >> 5) & 1, b = uid >> 6; h = kvh * 4 + g; row0 = b * SEQ + qb * 256; kv0 = b * KVS; seq = KVS; }
        else { const int u2 = uid - 2048; h = u2 & 7; const int b = u2 >> 3; row0 = ML + b * CTXL; kv0 = b * KVS + SEQ; seq = CTXL; }
        const int kvh = h >> 2;
        const float* cs_u = uid < 2048 ? (const float*)(F.ws + WS_ROPE) + (size_t)(row0 & 2047) * 64 : nullptr; const float* sn_u = cs_u ? cs_u + SEQ * 64 : nullptr;
        attn::attn_dense_body<attn::bf16>((const attn::bf16*)(Q + (size_t)row0 * DM + h * 128), Kb + (size_t)kv0 * 256 + kvh * 128, Vb + (size_t)kv0 * 256 + kvh * 128,
                                          Q + (size_t)row0 * DM + h * 128, seq, F.ldsg, qg, cs_u, sn_u);
        __syncthreads();
    }
}
namespace ml {
constexpr int LDQ = 272, LDT = 144;
constexpr int OFF_QS = 0, OFF_QW = 17408, OFF_KS = 34816, OFF_KWT = 52224, OFF_VT = 70656, OFF_SW = 107520, OFF_VEC = 116736;
constexpr int VEC_STRIDE = 1296, OFF_RDN = OFF_VEC + 2 * VEC_STRIDE, OFF_N = OFF_RDN + 256, OFF_CW = OFF_N + 512, LDS_END = OFF_CW + 4096;
static_assert(LDS_END <= 131072, "mlstm lds");
__device__ __forceinline__ int crow(int r, int hi) { return (r & 3) + 8 * (r >> 2) + 4 * hi; }
}
__device__ __forceinline__ float wave_scan_add(float x) {
    x += __builtin_bit_cast(float, __builtin_amdgcn_update_dpp(0, __builtin_bit_cast(int, x), 0x111, 0xf, 0xf, false));
    x += __builtin_bit_cast(float, __builtin_amdgcn_update_dpp(0, __builtin_bit_cast(int, x), 0x112, 0xf, 0xf, false));
    x += __builtin_bit_cast(float, __builtin_amdgcn_update_dpp(0, __builtin_bit_cast(int, x), 0x114, 0xf, 0xf, false));
    x += __builtin_bit_cast(float, __builtin_amdgcn_update_dpp(0, __builtin_bit_cast(int, x), 0x118, 0xf, 0xf, false));
    x += __builtin_bit_cast(float, __builtin_amdgcn_update_dpp(0, __builtin_bit_cast(int, x), 0x142, 0xa, 0xf, false));
    x += __builtin_bit_cast(float, __builtin_amdgcn_update_dpp(0, __builtin_bit_cast(int, x), 0x143, 0xc, 0xf, false));
    return x;
}
__device__ __forceinline__ float wave_scan_max(float x) {
    const int ninf = (int)0xff800000u;
    x = fmaxf(x, __builtin_bit_cast(float, __builtin_amdgcn_update_dpp(ninf, __builtin_bit_cast(int, x), 0x111, 0xf, 0xf, false)));
    x = fmaxf(x, __builtin_bit_cast(float, __builtin_amdgcn_update_dpp(ninf, __builtin_bit_cast(int, x), 0x112, 0xf, 0xf, false)));
    x = fmaxf(x, __builtin_bit_cast(float, __builtin_amdgcn_update_dpp(ninf, __builtin_bit_cast(int, x), 0x114, 0xf, 0xf, false)));
    x = fmaxf(x, __builtin_bit_cast(float, __builtin_amdgcn_update_dpp(ninf, __builtin_bit_cast(int, x), 0x118, 0xf, 0xf, false)));
    x = fmaxf(x, __builtin_bit_cast(float, __builtin_amdgcn_update_dpp(ninf, __builtin_bit_cast(int, x), 0x142, 0xa, 0xf, false)));
    x = fmaxf(x, __builtin_bit_cast(float, __builtin_amdgcn_update_dpp(ninf, __builtin_bit_cast(int, x), 0x143, 0xc, 0xf, false)));
    return x;
}
__device__ __forceinline__ void mlstm_scan(Ctx& F, bf16_t* HD, const float* conv_w, const float* conv_b) {
    using namespace ml;
    const bf16_t* P = (const bf16_t*)(F.ws + WS_BIG); const float* G = (const float*)(F.ws + WS_G);
    LAS unsigned char* L = F.lds;
    const int w = F.wave;
    for (int unit = F.bid; unit < 256; unit += F.G) {
        const int b = unit >> 3, h = (unit >> 1) & 3, dir0 = unit & 1;
        f32x16 Cst[4];
#pragma unroll
        for (int dt = 0; dt < 4; ++dt)
#pragma unroll
            for (int r = 0; r < 16; ++r) Cst[dt][r] = 0.f;
        float nreg = 0.f, mst = 0.f;
        if (F.tid < 128) ((LAS float*)(L + OFF_N))[F.tid] = 0.f;
        for (int i = F.tid; i < 1024; i += NTHR) { const int j = i & 3, ci = i >> 2; const int ch = (ci < 128 ? 0 : 512 - 128) + h * 128 + ci;
            ((LAS float*)(L + OFF_CW))[i] = j < 3 ? conv_w[j * 1024 + ch] : conv_b[ch]; }
        __syncthreads();
        v4u pq[4], ph[4], pv[4]; float pig = 0.f, pfg = 0.f;
#define ML_GEOM(cx, isctx_, rowbase_, t0_, Lseq_) const bool isctx_ = (cx) < 4; const int cc_##isctx_ = isctx_ ? (dir0 ? 3 - (cx) : (cx)) : (dir0 ? 31 - ((cx) - 4) : ((cx) - 4)); \
            const int rowbase_ = isctx_ ? ML + b * CTXL + 64 * cc_##isctx_ : b * SEQ + 64 * cc_##isctx_; const int t0_ = 64 * cc_##isctx_, Lseq_ = isctx_ ? CTXL : SEQ;
#define ML_PREFETCH(cx) do { ML_GEOM(cx, ic_, rb_, tz_, ls_) int ln_ = F.lane; asm volatile("" : "+v"(ln_)); \
            const bf16_t* prow_ = P + (size_t)(rb_ + ln_) * PLD; int hr_ = ln_ < 32 ? rb_ - 1 : rb_ + 64; if (tz_ == 0 && ln_ < 32) hr_ = rb_; if (tz_ + 64 >= ls_ && ln_ >= 32) hr_ = rb_ + 63; \
            const bf16_t* hrow_ = P + (size_t)hr_ * PLD; \
            if (!(ic_ && w < 4)) { const int cb_ = (w < 4 ? 0 : 512) + h * 128 + 32 * (w & 3); \
                _Pragma("unroll") for (int g8 = 0; g8 < 4; ++g8) { pq[g8] = *(const v4u*)(prow_ + cb_ + 8 * g8); ph[g8] = *(const v4u*)(hrow_ + cb_ + 8 * g8); } } \
            _Pragma("unroll") for (int g8 = 0; g8 < 4; ++g8) pv[g8] = *(const v4u*)(prow_ + 1024 + h * 256 + 32 * w + 8 * g8); \
            } while (0)
#define ML_GATELOAD(cx) do { ML_GEOM(cx, ig_, rg_, tg_, lg_) (void)tg_; (void)lg_; int ln_ = F.lane; asm volatile("" : "+v"(ln_)); const int ti_ = dir0 ? 63 - ln_ : ln_; \
            const float* gp_ = G + (size_t)(rg_ + ti_) * 16; pig = gp_[(2 * dir0) * 4 + h]; pfg = gp_[(2 * dir0 + 1) * 4 + h]; } while (0)
#define ML_GATES(cx) do { LAS float* vg_ = (LAS float*)(L + OFF_VEC + ((cx) & 1) * VEC_STRIDE); int ln_ = F.lane; asm volatile("" : "+v"(ln_)); const int ti_ = dir0 ? 63 - ln_ : ln_; \
            const float fl_ = fminf(pfg, 0.f) - log1pf(expf(-fabsf(pfg))); const float bc_ = wave_scan_add(fl_); \
            const float a_ = pig - bc_; const float pm_ = wave_scan_max(a_); \
            const float M_ = fmaxf(mst, pm_); const float Ml_ = __shfl(M_, 63), bl_ = __shfl(bc_, 63); \
            vg_[ti_] = a_; vg_[64 + ti_] = M_; vg_[128 + ti_] = expf(mst - M_); vg_[192 + ti_] = bc_ + M_; vg_[256 + ti_] = expf(a_ - Ml_); \
            if (ln_ == 0) vg_[320] = expf(mst - Ml_); \
            mst = bl_ + Ml_; } while (0)
        ML_PREFETCH(0);
        if (w == 4) { ML_GATELOAD(0); ML_GATES(0); ML_GATELOAD(1); }
#define ML_LBAR() do { asm volatile("s_waitcnt lgkmcnt(0)" ::: "memory"); __builtin_amdgcn_s_barrier(); asm volatile("" ::: "memory"); } while (0)
        ML_LBAR();
        for (int c = 0; c < 36; ++c) {
            ML_GEOM(c, isctx, rowbase, t0, Lseq)
            LAS float* vec = (LAS float*)(L + OFF_VEC + (c & 1) * VEC_STRIDE);
            int lane_c = F.lane, dir_c = dir0; asm volatile("" : "+v"(lane_c), "+s"(dir_c));
            const int lane = lane_c, r32 = lane & 31, hi = lane >> 5, dir = dir_c;
            {
                const int ti = lane, t = t0 + ti;
                const bool hasp = t >= 1, hasn = t + 1 < Lseq;
                const float wi = vec[128 + ti], wk = vec[256 + ti];
                if (!(isctx && w < 4)) {
                    const bool isq = w < 4; const int dbase = 32 * (w & 3);
#pragma unroll
                    for (int g8 = 0; g8 < 4; ++g8) {
                        const v4u cur = pq[g8], hal = ph[g8];
                        v4u prv, nxt;
                        prv.x = __shfl_up(cur.x, 1); prv.y = __shfl_up(cur.y, 1); prv.z = __shfl_up(cur.z, 1); prv.w = __shfl_up(cur.w, 1);
                        nxt.x = __shfl_down(cur.x, 1); nxt.y = __shfl_down(cur.y, 1); nxt.z = __shfl_down(cur.z, 1); nxt.w = __shfl_down(cur.w, 1);
                        if (lane == 0) prv = hal;
                        if (lane == 63) nxt = hal;
                        if (!hasp) prv = (v4u){0u, 0u, 0u, 0u};
                        if (!hasn) nxt = (v4u){0u, 0u, 0u, 0u};
                        float y[8];
#pragma unroll
                        for (int e2 = 0; e2 < 4; ++e2) {
                            const unsigned pc = e2 == 0 ? prv.x : e2 == 1 ? prv.y : e2 == 2 ? prv.z : prv.w;
                            const unsigned cu = e2 == 0 ? cur.x : e2 == 1 ? cur.y : e2 == 2 ? cur.z : cur.w;
                            const unsigned nx = e2 == 0 ? nxt.x : e2 == 1 ? nxt.y : e2 == 2 ? nxt.z : nxt.w;
                            const LAS f32x4* cw = (const LAS f32x4*)(L + OFF_CW) + (isq ? 0 : 128) + dbase + 8 * g8 + 2 * e2;
                            const f32x4 ca = cw[0], cb = cw[1];
                            y[2 * e2] = ca[0] * bflo(pc) + ca[1] * bflo(cu) + ca[2] * bflo(nx) + ca[3];
                            y[2 * e2 + 1] = cb[0] * bfhi(pc) + cb[1] * bfhi(cu) + cb[2] * bfhi(nx) + cb[3];
                        }
#pragma unroll
                        for (int e = 0; e < 8; ++e) y[e] = siluf(y[e]);
                        const int dd = dbase + 8 * g8;
                        if (isq) {
                            v4u o; o.x = cvtpk(y[0], y[1]); o.y = cvtpk(y[2], y[3]); o.z = cvtpk(y[4], y[5]); o.w = cvtpk(y[6], y[7]);
                            *(LAS v4u*)(L + OFF_QS + ti * LDQ + dd * 2) = o;
                            o.x = cvtpk(y[0] * wi, y[1] * wi); o.y = cvtpk(y[2] * wi, y[3] * wi); o.z = cvtpk(y[4] * wi, y[5] * wi); o.w = cvtpk(y[6] * wi, y[7] * wi);
                            *(LAS v4u*)(L + OFF_QW + ti * LDQ + dd * 2) = o;
                        } else {
#pragma unroll
                            for (int e = 0; e < 8; ++e) y[e] *= 0.08838834764831845f;
                            v4u o; o.x = cvtpk(y[0], y[1]); o.y = cvtpk(y[2], y[3]); o.z = cvtpk(y[4], y[5]); o.w = cvtpk(y[6], y[7]);
                            *(LAS v4u*)(L + OFF_KS + ti * LDQ + dd * 2) = o;
#pragma unroll
                            for (int e = 0; e < 8; ++e) *(LAS unsigned short*)(L + OFF_KWT + (dd + e) * LDT + ti * 2) = (unsigned short)(cvtpk(y[e] * wk, 0.f) & 0xffffu);
                        }
                    }
                }
#pragma unroll
                for (int g8 = 0; g8 < 4; ++g8) {
                    const int vv = 32 * w + 8 * g8;
                    const v4u cur = pv[g8];
                    const unsigned ws4[4] = {cur.x, cur.y, cur.z, cur.w};
#pragma unroll
                    for (int e2 = 0; e2 < 4; ++e2) {
                        *(LAS unsigned short*)(L + OFF_VT + (vv + 2 * e2) * LDT + ti * 2) = (unsigned short)(ws4[e2] & 0xffffu);
                        *(LAS unsigned short*)(L + OFF_VT + (vv + 2 * e2 + 1) * LDT + ti * 2) = (unsigned short)(ws4[e2] >> 16);
                    }
                }
                if (c + 1 < 36) ML_PREFETCH(c + 1);
            }
            ML_LBAR();
            if (w == 4 && c + 1 < 36) { ML_GATES(c + 1); if (c + 2 < 36) ML_GATELOAD(c + 2); }
            if (!isctx) {
                if (w < 4) {
                    const int st = w & 1, tt = w >> 1;
                    f32x16 acc;
#pragma unroll
                    for (int r = 0; r < 16; ++r) acc[r] = 0.f;
                    const LAS unsigned char* ap = L + OFF_KS + (32 * st + r32) * LDQ + hi * 16;
                    const LAS unsigned char* bp = L + OFF_QS + (32 * tt + r32) * LDQ + hi * 16;
#pragma unroll
                    for (int ks = 0; ks < 8; ++ks) acc = __builtin_amdgcn_mfma_f32_32x32x16_bf16(*(const LAS bf16x8*)(ap + ks * 32), *(const LAS bf16x8*)(bp + ks * 32), acc, 0, 0, 0);
                    const int t = 32 * tt + r32, jt = dir ? 63 - t : t; const float Mt = vec[64 + t];
#pragma unroll
                    for (int q = 0; q < 4; ++q) {
                        float vals[4];
#pragma unroll
                        for (int e = 0; e < 4; ++e) { const int s = 32 * st + 8 * q + 4 * hi + e, js = dir ? 63 - s : s;
                            const float wgt = js <= jt ? __expf(vec[s] - Mt) : 0.f; vals[e] = acc[4 * q + e] * wgt; }
                        v2u o; o.x = cvtpk(vals[0], vals[1]); o.y = cvtpk(vals[2], vals[3]);
                        *(LAS v2u*)(L + OFF_SW + t * LDT + (32 * st + 8 * q + 4 * hi) * 2) = o;
                    }
                }
                ML_LBAR();
                {
                    const int t = F.tid >> 3, p = F.tid & 7;
                    const v4u sw = *(const LAS v4u*)(L + OFF_SW + t * LDT + 16 * p);
                    float d = (bflo(sw.x) + bfhi(sw.x)) + (bflo(sw.y) + bfhi(sw.y)) + (bflo(sw.z) + bfhi(sw.z)) + (bflo(sw.w) + bfhi(sw.w));
                    const LAS float* nl = (const LAS float*)(L + OFF_N) + 16 * p;
#pragma unroll
                    for (int hq = 0; hq < 2; ++hq) { const v4u qw = *(const LAS v4u*)(L + OFF_QW + t * LDQ + 32 * p + 16 * hq); const LAS float* n8 = nl + 8 * hq;
                        d += bflo(qw.x) * n8[0] + bfhi(qw.x) * n8[1] + bflo(qw.y) * n8[2] + bfhi(qw.y) * n8[3] + bflo(qw.z) * n8[4] + bfhi(qw.z) * n8[5] + bflo(qw.w) * n8[6] + bfhi(qw.w) * n8[7]; }
                    d += __shfl_xor(d, 1); d += __shfl_xor(d, 2); d += __shfl_xor(d, 4);
                    if (p == 0) ((LAS float*)(L + OFF_RDN))[t] = 1.f / fmaxf(fabsf(d), expf(-vec[192 + t]));
                }
                ML_LBAR();
                bf16x8 Cb[4][2];
#pragma unroll
                for (int dt = 0; dt < 4; ++dt)
#pragma unroll
                    for (int jp = 0; jp < 2; ++jp) { v4u o; o.x = cvtpk(Cst[dt][8 * jp + 0], Cst[dt][8 * jp + 1]); o.y = cvtpk(Cst[dt][8 * jp + 2], Cst[dt][8 * jp + 3]);
                        o.z = cvtpk(Cst[dt][8 * jp + 4], Cst[dt][8 * jp + 5]); o.w = cvtpk(Cst[dt][8 * jp + 6], Cst[dt][8 * jp + 7]); Cb[dt][jp] = __builtin_bit_cast(bf16x8, o); }
                const LAS unsigned char* vtp = L + OFF_VT + (32 * w + r32) * LDT + hi * 16;
#pragma unroll
                for (int tt = 0; tt < 2; ++tt) {
                    f32x16 acc;
#pragma unroll
                    for (int r = 0; r < 16; ++r) acc[r] = 0.f;
                    const LAS unsigned char* swp = L + OFF_SW + (32 * tt + r32) * LDT + hi * 16;
#pragma unroll
                    for (int ks = 0; ks < 4; ++ks) acc = __builtin_amdgcn_mfma_f32_32x32x16_bf16(*(const LAS bf16x8*)(vtp + ks * 32), *(const LAS bf16x8*)(swp + ks * 32), acc, 0, 0, 0);
                    const LAS unsigned char* qwp = L + OFF_QW + (32 * tt + r32) * LDQ + hi * 8;
#pragma unroll
                    for (int dt = 0; dt < 4; ++dt)
#pragma unroll
                        for (int jp = 0; jp < 2; ++jp) {
                            const v2u lo = *(const LAS v2u*)(qwp + (32 * dt + 16 * jp) * 2), hi2 = *(const LAS v2u*)(qwp + (32 * dt + 16 * jp + 8) * 2);
                            v4u bv; bv.x = lo.x; bv.y = lo.y; bv.z = hi2.x; bv.w = hi2.y;
                            acc = __builtin_amdgcn_mfma_f32_32x32x16_bf16(Cb[dt][jp], __builtin_bit_cast(bf16x8, bv), acc, 0, 0, 0);
                        }
                    const int t = 32 * tt + r32; const float rdn_t = ((const LAS float*)(L + OFF_RDN))[t];
                    bf16_t* hrow = HD + ((size_t)dir * ML + rowbase + t) * DM + h * 256 + 32 * w + 4 * hi;
#pragma unroll
                    for (int q = 0; q < 4; ++q) { v2u o; o.x = cvtpk(acc[4 * q] * rdn_t, acc[4 * q + 1] * rdn_t); o.y = cvtpk(acc[4 * q + 2] * rdn_t, acc[4 * q + 3] * rdn_t);
                        *(v2u*)(hrow + 8 * q) = o; }
                }
            }
            {
                const float decay = vec[320];
                const LAS unsigned char* vtp = L + OFF_VT + (32 * w + r32) * LDT + hi * 16;
                bf16x8 vb[4];
#pragma unroll
                for (int ks = 0; ks < 4; ++ks) vb[ks] = *(const LAS bf16x8*)(vtp + ks * 32);
#pragma unroll
                for (int dt = 0; dt < 4; ++dt) {
#pragma unroll
                    for (int r = 0; r < 16; ++r) Cst[dt][r] *= decay;
                    const LAS unsigned char* kp = L + OFF_KWT + (32 * dt + r32) * LDT + hi * 16;
#pragma unroll
                    for (int ks = 0; ks < 4; ++ks) Cst[dt] = __builtin_amdgcn_mfma_f32_32x32x16_bf16(*(const LAS bf16x8*)(kp + ks * 32), vb[ks], Cst[dt], 0, 0, 0);
                }
                if (F.tid < 128) {
                    float s = 0.f;
#pragma unroll
                    for (int i = 0; i < 8; ++i) { const v4u kw = *(const LAS v4u*)(L + OFF_KWT + F.tid * LDT + 16 * i);
                        s += (bflo(kw.x) + bfhi(kw.x)) + (bflo(kw.y) + bfhi(kw.y)) + (bflo(kw.z) + bfhi(kw.z)) + (bflo(kw.w) + bfhi(kw.w)); }
                    nreg = decay * nreg + s;
                    ((LAS float*)(L + OFF_N))[F.tid] = nreg;
                }
            }
            ML_LBAR();
        }
        __syncthreads();
    }
}
__device__ __forceinline__ void mlstm_readout(Ctx& F, const bf16_t* HD, const float* ng) {
    const bf16_t* P = (const bf16_t*)(F.ws + WS_BIG); bf16_t* A2 = (bf16_t*)(F.ws + WS_XM);
    const int gw = F.bid * NWAVES + F.wave, NGW = F.G * NWAVES;
    constexpr int RP = 2;
    for (int row0 = gw * RP; row0 < ML; row0 += NGW * RP) {
        const int col = 16 * F.lane;
        v4u ra[RP][2], rb[RP][2], ro[RP][2];
#pragma unroll
        for (int r = 0; r < RP; ++r)
#pragma unroll
            for (int i = 0; i < 2; ++i) { const int row = row0 + r;
                ra[r][i] = *(const v4u*)(HD + (size_t)row * DM + col + 8 * i); rb[r][i] = *(const v4u*)(HD + ((size_t)ML + row) * DM + col + 8 * i); ro[r][i] = *(const v4u*)(P + (size_t)row * PLD + 2048 + col + 8 * i); }
        float ngv[16];
#pragma unroll
        for (int e = 0; e < 16; ++e) ngv[e] = ng[col + e];
#pragma unroll
        for (int r = 0; r < RP; ++r) {
            const int row = row0 + r;
            float s[16], o[16];
#pragma unroll
            for (int i = 0; i < 2; ++i) {
                const unsigned aw[4] = {ra[r][i].x, ra[r][i].y, ra[r][i].z, ra[r][i].w}, bw[4] = {rb[r][i].x, rb[r][i].y, rb[r][i].z, rb[r][i].w}, ow[4] = {ro[r][i].x, ro[r][i].y, ro[r][i].z, ro[r][i].w};
#pragma unroll
                for (int e = 0; e < 4; ++e) { s[8 * i + 2 * e] = bflo(aw[e]) + bflo(bw[e]); s[8 * i + 2 * e + 1] = bfhi(aw[e]) + bfhi(bw[e]); o[8 * i + 2 * e] = bflo(ow[e]); o[8 * i + 2 * e + 1] = bfhi(ow[e]); }
            }
            float sum = 0.f;
#pragma unroll
            for (int e = 0; e < 16; ++e) sum += s[e];
            sum += __shfl_xor(sum, 1); sum += __shfl_xor(sum, 2); sum += __shfl_xor(sum, 4); sum += __shfl_xor(sum, 8);
            const float mu = sum * (1.f / 256.f); float q = 0.f;
#pragma unroll
            for (int e = 0; e < 16; ++e) { s[e] -= mu; q += s[e] * s[e]; }
            q += __shfl_xor(q, 1); q += __shfl_xor(q, 2); q += __shfl_xor(q, 4); q += __shfl_xor(q, 8);
            const float rstd = 1.f / sqrtf(q * (1.f / 256.f) + LN_EPS);
            float y[16];
#pragma unroll
            for (int e = 0; e < 16; ++e) y[e] = s[e] * rstd * ngv[e] * __builtin_amdgcn_rcpf(1.f + __expf(-o[e]));
#pragma unroll
            for (int i = 0; i < 2; ++i) { v4u wv; wv.x = cvtpk(y[8 * i], y[8 * i + 1]); wv.y = cvtpk(y[8 * i + 2], y[8 * i + 3]); wv.z = cvtpk(y[8 * i + 4], y[8 * i + 5]); wv.w = cvtpk(y[8 * i + 6], y[8 * i + 7]);
                *(v4u*)(A2 + (size_t)row * DM + col + 8 * i) = wv; }
        }
    }
}
constexpr int N_PHASES = 24;

template <class Epi>
__device__ __forceinline__ void run_gemm(Ctx& F, const bf16_t* A, const bf16_t* Bt, int M, int N, int K, const Epi& E, int rev = 0, int vG = 0, int pm_off = 0, unsigned long long pn_map = 0ull) {
    pg8::Gemm g{A, Bt, M + pm_off * 256, N, K}; pg8::StaticOrder S; S.init(M, N, vG ? vG : F.G, F.bid, rev, pm_off); S.pn_map = pn_map;
    pg8::gemm_phase<Epi, pg8::StaticOrder, true, true>(F.lds, g, S, E);
}
__device__ __forceinline__ void grid_barrier(Ctx& F) {
    relane(F); XcdBarrier xb_; xb_.bar = (unsigned*)(F.ws + WS_CTL); xb_.x = xb_xcc_id(); xb_.st = (volatile LAS unsigned*)(F.lds + XB_LDS_OFF); xcd_barrier(xb_);
}
template <class Epi>
__device__ __forceinline__ void ffn2_rowpass(Ctx& F, const Epi& E, const bf16_t* W2t, const float* g, const float* bta, const float* MODx, int shift_idx, int scale_idx) {
    const bf16_t* HID = (const bf16_t*)(F.ws + WS_BIG);
    if (F.G != 256) {
        run_gemm(F, HID, W2t, MT, DM, DFF, E, 1); grid_barrier(F);
        relane(F); row_pass<1>(F, nullptr, nullptr, 0, MT, F.bid, F.G, g, bta, MODx, shift_idx, scale_idx); return; }
    constexpr int R1 = 57344;
    run_gemm(F, HID, W2t, ML, DM, DFF, E, 1);
    grid_barrier(F);
    if (F.bid < 128) run_gemm(F, HID, W2t, MC, DM, DFF, E, 0, 128, ML / 256);
    else row_pass<1>(F, nullptr, nullptr, 0, R1, F.bid - 128, 128, g, bta, MODx, shift_idx, scale_idx);
    grid_barrier(F);
    row_pass<1>(F, nullptr, nullptr, R1, MT, F.bid, F.G, g, bta, MODx, shift_idx, scale_idx);
}
#ifndef REP_FFN1
#define REP_FFN1 1
#endif
#ifndef REP_SCAN
#define REP_SCAN 1
#endif
#ifndef REP_XM0
#define REP_XM0 1
#endif
#ifndef PH_LO
#define PH_LO 0
#endif
#ifndef PH_HI
#define PH_HI N_PHASES
#endif
constexpr int lo = PH_LO, hi = PH_HI;
#ifndef CATS
#define CATS 0xff
#endif
#ifndef GSEL
#define GSEL 0xf
#endif
#define CAT_P0 ((CATS & 1) != 0)
#define CAT_ROW ((CATS & 2) != 0)
#define CAT_GEMM ((CATS & 4) != 0)
#define CAT_ATTN ((CATS & 8) != 0)
#define CAT_ML ((CATS & 16) != 0)
#define CAT_QKN ((CATS & 32) != 0)
#define IN(k) (lo <= (k) && (k) < hi)
#define SEAM(k) do { if (IN(k) && IN((k) + 1)) { grid_barrier(F); } } while (0)
#define H ((_Float16*)(F.ws + WS_H))
#define XM ((bf16_t*)(F.ws + WS_XM))
#define BIG ((bf16_t*)(F.ws + WS_BIG))
#define MOD ((const float*)(F.ws + WS_MOD))
#define ln_g ARG_IN(6)
#define ln_b ARG_IN(7)
#define STATS ((const float*)(F.ws + WS_STATS))

template <int l>
__device__ __forceinline__ void layer_body(Ctx& F) {

        const int pb = 2 + 11 * l;
#define MODl (MOD + (size_t)l * 33 * NMODC)
        const int Mmix = (l == 0) ? MT : ML;
        {
        if (CAT_GEMM && IN(pb + 0)) { relane(F); EpiSwiglu E{BIG}; if (GSEL & 1) run_gemm(F, XM, (const bf16_t*)(F.ws + WS_W1 + (size_t)(2 * l) * W1_SZ), MT, NFF1, DM, E); } }
        SEAM(pb + 0);
        if (CAT_GEMM && IN(pb + 1)) { relane(F);
            if (l == 0) { EpiResid<false, 1> E{ARG_IN(0), ARG_IN(2), H, MODl + 2 * DM, nullptr, nullptr, nullptr};
                ffn2_rowpass(F, E, (const bf16_t*)(F.ws + WS_W2 + (size_t)(2 * l) * W2_SZ), ln_g + (l * 3 + 0) * DM, ln_b + (l * 3 + 0) * DM, MODl, 3, 4); }
            else { EpiResid<true, 1> E{nullptr, nullptr, H, MODl + 2 * DM, STATS, ln_g + 2 * DM, ln_b + 2 * DM};
                ffn2_rowpass(F, E, (const bf16_t*)(F.ws + WS_W2 + (size_t)(2 * l) * W2_SZ), ln_g + (l * 3 + 0) * DM, ln_b + (l * 3 + 0) * DM, MODl, 3, 4); } }
        SEAM(pb + 2);
        if (l == 0) {
            if (CAT_GEMM && IN(pb + 3)) { relane(F); EpiQKV E{(bf16_t*)(F.ws + WS_Q), (bf16_t*)(F.ws + WS_K), (bf16_t*)(F.ws + WS_V)}; if (GSEL & 4) run_gemm(F, XM, (const bf16_t*)(F.ws + WS_WQKV), MT, NQKV, DM, E); }
            SEAM(pb + 3);
            if (CAT_QKN && IN(pb + 4)) relane(F), qknorm_rope(F, ARG_IN(11), ARG_IN(12));
            SEAM(pb + 4);
            if (CAT_ATTN && IN(pb + 5)) { relane(F); attn_phase(F, ARG_IN(11)); }
            SEAM(pb + 5);
            if (CAT_GEMM && IN(pb + 6)) { relane(F); EpiResid<true, 2> E{nullptr, nullptr, H, MODl + 5 * DM, STATS, ln_g + (l * 3 + 0) * DM, ln_b + (l * 3 + 0) * DM}; if (GSEL & 2) run_gemm(F, (const bf16_t*)(F.ws + WS_Q), (const bf16_t*)(F.ws + WS_WOA), MT, DM, DM, E); }
            SEAM(pb + 6);
        } else {
            bf16_t* HD = (bf16_t*)F.out;
            if (CAT_GEMM && IN(pb + 3)) { relane(F); EpiMlIn E{BIG, (float*)(F.ws + WS_G), ARG_IN(15)}; if (GSEL & 8) run_gemm(F, XM, (const bf16_t*)(F.ws + WS_WMI), MT, NMLPAD, DM, E); }
            SEAM(pb + 3);
            {
            if (CAT_ML && IN(pb + 4)) relane(F), mlstm_scan(F, HD, ARG_IN(16), ARG_IN(17)); }
            SEAM(pb + 4);
            if (CAT_ML && IN(pb + 5)) relane(F), mlstm_readout(F, HD, ARG_IN(18));
            SEAM(pb + 5);
            if (CAT_GEMM && IN(pb + 6)) { relane(F); EpiResid<true, 2> E{nullptr, nullptr, H, MODl + 5 * DM, STATS, ln_g + (l * 3 + 0) * DM, ln_b + (l * 3 + 0) * DM}; if (GSEL & 2) run_gemm(F, XM, (const bf16_t*)(F.ws + WS_WMO), ML, DM, DM, E); }
            SEAM(pb + 6);
        }
        if (CAT_ROW && IN(pb + 7)) relane(F), row_pass<1>(F, nullptr, nullptr, 0, Mmix, F.bid, F.G, ln_g + (l * 3 + 1) * DM, ln_b + (l * 3 + 1) * DM, MODl, 6, 7);
        SEAM(pb + 7);
        if (CAT_GEMM && IN(pb + 8)) { relane(F); EpiSwiglu E{BIG}; if (GSEL & 1) run_gemm(F, XM, (const bf16_t*)(F.ws + WS_W1 + (size_t)(2 * l + 1) * W1_SZ), Mmix, NFF1, DM, E); }
        SEAM(pb + 8);
        if (l == 0) {
            if (CAT_GEMM && IN(pb + 9)) { relane(F); EpiResid<true, 1> E{nullptr, nullptr, H, MODl + 8 * DM, STATS, ln_g + (l * 3 + 1) * DM, ln_b + (l * 3 + 1) * DM};
                ffn2_rowpass(F, E, (const bf16_t*)(F.ws + WS_W2 + (size_t)(2 * l + 1) * W2_SZ), ln_g + 2 * DM, ln_b + 2 * DM, MOD + (size_t)33 * NMODC, 0, 1); }
        } else {
            if (CAT_GEMM && IN(pb + 9)) { relane(F); EpiResid<true, 1> E{nullptr, nullptr, H, MODl + 8 * DM, STATS, ln_g + (l * 3 + 1) * DM, ln_b + (l * 3 + 1) * DM}; run_gemm(F, BIG, (const bf16_t*)(F.ws + WS_W2 + (size_t)(2 * l + 1) * W2_SZ), Mmix, DM, DFF, E, 1); }
            SEAM(pb + 9);
            if (CAT_ROW && IN(pb + 10)) relane(F), row_pass<2>(F, nullptr, nullptr, 0, ML, F.bid, F.G, ln_g + 5 * DM, ln_b + 5 * DM, MODl, 0, 1);
        }
        SEAM(pb + 10);
}

__global__ void __launch_bounds__(NTHR, 2) fwd_megakernel(Args args) {
    extern __shared__ __attribute__((aligned(16))) unsigned char lds_raw[];
    cg::grid_group grid = cg::this_grid();
    Ctx F;
    F.lds = (LAS unsigned char*)lds_raw; F.ldsg = (char*)lds_raw;
    relane(F);
    if (F.tid < 64) ((LAS unsigned*)(F.lds + XB_LDS_OFF))[F.tid] = 0u;
    __syncthreads();
    if (karg_u64(176) == 0x1234567812345678ull) cg::this_grid().sync();
    (void)xcd_barrier_post((unsigned*)(F.ws + WS_CTL), (volatile LAS unsigned*)(F.lds + XB_LDS_OFF));
    if (CAT_P0 && IN(0)) { p0_weights(F, ARG_IN(8), ARG_IN(9), ARG_IN(10), ARG_IN(13), ARG_IN(14), ARG_IN(19)); __syncthreads(); p0_mods(F, ARG_IN(1), ARG_IN(3), ARG_IN(4), ARG_IN(5)); p0_rope(F); }
    SEAM(0);
    {
    if (CAT_ROW && IN(1)) relane(F), row_pass<0>(F, ARG_IN(0), ARG_IN(2), 0, MT, F.bid, F.G, nullptr, nullptr, MOD, 0, 1); }
    SEAM(1);
    layer_body<0>(F);
    layer_body<1>(F);
#undef H
#undef XM
#undef BIG
#undef MOD
#undef MODl
#undef ln_g
#undef ln_b
#undef STATS
#undef IN
#undef SEAM
}

extern "C" void kernel_launch(void* const* d_in, const int* in_sizes, int n_in, void* d_out, int out_size, void* d_ws, size_t ws_size, hipStream_t stream) {
    static int grid_blocks = 0;
    if (!grid_blocks) {
        if (n_in != 20 || out_size != ML * DM || ws_size < WS_END) { fprintf(stderr, "kernel_launch: unexpected shapes: n_in %d out %d ws %zu (need %zu)\n", n_in, out_size, ws_size, (size_t)WS_END); return; }
        int dev = 0, cus = 0, per_cu = 0;
        hipGetDevice(&dev);
        hipDeviceGetAttribute(&cus, hipDeviceAttributeMultiprocessorCount, dev);
        if (hipFuncSetAttribute((const void*)fwd_megakernel, hipFuncAttributeMaxDynamicSharedMemorySize, LDS_BYTES) != hipSuccess) { fprintf(stderr, "kernel_launch: hipFuncSetAttribute failed\n"); return; }
        hipOccupancyMaxActiveBlocksPerMultiprocessor(&per_cu, fwd_megakernel, NTHR, LDS_BYTES);
        if (per_cu < 1) { fprintf(stderr, "kernel_launch: occupancy query says 0 blocks per CU\n"); return; }
        grid_blocks = cus * 1;
    }
    if (hipMemsetAsync((char*)d_ws + WS_CTL, 0, XCD_BAR_WORDS * 4, stream) != hipSuccess) { fprintf(stderr, "kernel_launch: memset failed\n"); return; }
    Args a{};
    for (int i = 0; i < 20; ++i) a.in[i] = (const float*)d_in[i];
    a.out = (float*)d_out; a.ws = (unsigned char*)d_ws; a.ph_lo = 0; a.ph_hi = N_PHASES;
    void* kargs[] = {&a};
    hipError_t e = hipLaunchCooperativeKernel((const void*)fwd_megakernel, dim3(grid_blocks), dim3(NTHR), kargs, LDS_BYTES, stream);
    if (e != hipSuccess) fprintf(stderr, "cooperative launch failed: %s (grid %d)\n", hipGetErrorString(e), grid_blocks);
}
```

```cpp
#include <hip/hip_runtime.h>
#include <hip/hip_bf16.h>
#include <hip/hip_cooperative_groups.h>
#include <cstdio>
#include <cstdint>
namespace cg = cooperative_groups;
namespace pg8 {
#define PG8_LAS __attribute__((address_space(3)))
typedef unsigned short bf16_t;
typedef short bf16x8 __attribute__((ext_vector_type(8)));
typedef float f32x4 __attribute__((ext_vector_type(4)));
typedef unsigned u32x4 __attribute__((ext_vector_type(4)));
constexpr int BM = 256, BK = 64, HALF = 128, HTB = HALF * BK * 2  , STAGE_BYTES = 8 * HTB, NXCD = 8, WGM = 8;

__host__ __device__ __forceinline__ int lds_byte(int r, int c) { const int st = (r >> 4) * 2 + (c >> 5), rr = r & 15, cc = c & 31, ob = rr * 64 + cc * 2; return st * 1024 + (ob ^ (((ob >> 9) & 1) << 5)); }
__host__ __device__ __forceinline__ void stage_rc(int b, int& R, int& C) { const int st = b / 1024, sb = b % 1024, swz = sb ^ (((sb >> 9) & 1) << 5); R = (st >> 1) * 16 + swz / 64; C = (st & 1) * 32 + (swz % 64) / 2; }
__host__ __device__ __forceinline__ int perm32(int rho) { const int n = rho >> 4, i = rho & 15; return 8 * (i >> 2) + 4 * n + (i & 3); }

struct Unit { int pm, pn; };
struct Gemm { const bf16_t* A; const bf16_t* Bt; int M, N, K; };

struct StaticOrder {
    int nM, nN, nwg, G, c, rev, pm_off, ext_units = 0, ext_rows = 1, ext_pm0 = 0; unsigned long long ext_map = 0ull;
    unsigned long long pn_map;
    __host__ __device__ void init(int M, int N, int G_, int c_, int rev_ = 0, int pm_off_ = 0) { nM = M / BM; nN = N / BM; nwg = nM * nN; G = G_; c = c_; rev = rev_; pm_off = pm_off_; pn_map = 0ull; }
    __host__ __device__ bool next(int i, Unit& u) const {
        const long L = (long)i * G + c;
        if (L >= nwg) { const int j = (int)(L - nwg); if (j >= ext_units) return false; u.pm = ext_pm0 + j % ext_rows; u.pn = (int)((ext_map >> (4 * (j / ext_rows))) & 15ull); return true; }
        int wgid = (int)L; { const int q = nwg / NXCD, r = nwg % NXCD, xcd = wgid % NXCD, off = wgid / NXCD; wgid = (xcd < r ? xcd * (q + 1) : r * (q + 1) + (xcd - r) * q) + off; }
        const int nig = WGM * nN, gid = wgid / nig, fm = gid * WGM, gsz = (nM - fm) < WGM ? (nM - fm) : WGM;
        u.pm = fm + ((wgid % nig) % gsz); u.pn = (wgid % nig) / gsz; if (rev) u.pm = nM - 1 - u.pm; u.pm += pm_off; if (pn_map) u.pn = (int)((pn_map >> (4 * u.pn)) & 15ull); return true;
    }
    __device__ __forceinline__ void a_ready(const Unit&) const {}
    __device__ __forceinline__ void done(const Unit&) const {}
};

__device__ __forceinline__ unsigned cvt_pk_bf16(float lo, float hi) { unsigned r; asm volatile("v_cvt_pk_bf16_f32 %0, %1, %2" : "=v"(r) : "v"(lo), "v"(hi)); return r; }
typedef float f32x2 __attribute__((ext_vector_type(2)));
__device__ __forceinline__ f32x2 gelu_pk(f32x2 v) {
    const f32x2 av = __builtin_elementwise_abs(v), d = av * 0.2316418882f + 1.0f;
    f32x2 t; t.x = __builtin_amdgcn_rcpf(d.x); t.y = __builtin_amdgcn_rcpf(d.y);
    f32x2 q = t * 0.5307027145f + (-0.7265760135f); q = q * t + 0.7107068705f; q = q * t + (-0.142248368f); q = q * t + 0.127414796f; q = q * t;
    const f32x2 s = (v * v) * (-0.72134752044f);
    f32x2 e; e.x = __builtin_amdgcn_exp2f(s.x); e.y = __builtin_amdgcn_exp2f(s.y);
    const f32x2 m = v * (q * e), r = v - m;
    f32x2 o; o.x = v.x < 0.f ? m.x : r.x; o.y = v.y < 0.f ? m.y : r.y; return o;
}

template <int ACT  > struct EpiBf16 {
    static constexpr bool PERM = true, AFTER_DRAIN = false; static_assert(ACT == 0 || ACT == 1, "EpiBf16: ACT is 0 (none) or 1 (gelu_pk)");
    bf16_t* O; int ldc; const float* bias; int split_cols; size_t split_stride; float scale0;
    __device__ __forceinline__ void operator()(const f32x4 (&acc)[2][2][4][2], const Unit& u, int wr, int wc, int fr, int fq) const {
        const int row0 = u.pm * BM + wr * 64 + fr; int colt = u.pn * BM; bf16_t* base = O;
        float sc = 1.f; if (split_cols) { const int t = colt / split_cols; base += (size_t)t * split_stride; colt -= t * split_cols; if (t == 0) sc = scale0; }
        const int col0 = colt + wc * 32 + 8 * fq, bcol0 = u.pn * BM + wc * 32 + 8 * fq;
        f32x4 bv[2][2];
#pragma unroll
        for (int bj = 0; bj < 2; ++bj)
#pragma unroll
            for (int n = 0; n < 2; ++n) bv[bj][n] = bias ? *(const f32x4*)(bias + bcol0 + bj * HALF + 4 * n) : (f32x4){0.f, 0.f, 0.f, 0.f};
#pragma unroll
        for (int ai = 0; ai < 2; ++ai)
#pragma unroll
            for (int m = 0; m < 4; ++m) { bf16_t* rowp = base + (size_t)(row0 + ai * HALF + m * 16) * ldc + col0;
#pragma unroll
                for (int bj = 0; bj < 2; ++bj) { f32x4 v0 = acc[ai][bj][m][0] + bv[bj][0], v1 = acc[ai][bj][m][1] + bv[bj][1];
                    if (ACT == 1) { f32x2 a = gelu_pk((f32x2){v0[0], v0[1]}), b = gelu_pk((f32x2){v0[2], v0[3]}), c = gelu_pk((f32x2){v1[0], v1[1]}), d = gelu_pk((f32x2){v1[2], v1[3]});
                        v0 = (f32x4){a.x, a.y, b.x, b.y}; v1 = (f32x4){c.x, c.y, d.x, d.y}; }
                    v0 = v0 * sc; v1 = v1 * sc; u32x4 w; w.x = cvt_pk_bf16(v0[0], v0[1]); w.y = cvt_pk_bf16(v0[2], v0[3]); w.z = cvt_pk_bf16(v1[0], v1[1]); w.w = cvt_pk_bf16(v1[2], v1[3]);
                    *(u32x4*)(rowp + bj * HALF) = w; } }
    }
};

struct PanelStats {
    unsigned* xbuf;
    unsigned* cnt;
    unsigned* tmo;
    int ntn; float eps;
    unsigned code;
    __device__ __forceinline__ bool run(const f32x4 (&v)[2][2][4][2], const Unit& u, int wr, int wc, int fr, int fq, PG8_LAS unsigned char* lds, int wid, int lane) const {
        typedef float f32x2v __attribute__((ext_vector_type(2)));
        PG8_LAS f32x2v* P = (PG8_LAS f32x2v*)lds;
        PG8_LAS f32x2v* S = (PG8_LAS f32x2v*)(lds + 8192);
        PG8_LAS unsigned* flag = (PG8_LAS unsigned*)(lds + 8192 + 2048);
#pragma unroll
        for (int ai = 0; ai < 2; ++ai)
#pragma unroll
            for (int m = 0; m < 4; ++m) {
                float s = 0.f;
#pragma unroll
                for (int bj = 0; bj < 2; ++bj)
#pragma unroll
                    for (int n = 0; n < 2; ++n) { const f32x4 x = v[ai][bj][m][n]; s += (x[0] + x[1]) + (x[2] + x[3]); }
                s += __shfl_xor(s, 16); s += __shfl_xor(s, 32);
                const float mw = s * (1.0f / 64.0f); float q = 0.f;
#pragma unroll
                for (int bj = 0; bj < 2; ++bj)
#pragma unroll
                    for (int n = 0; n < 2; ++n) { const f32x4 d = v[ai][bj][m][n] - mw; q += (d[0] * d[0] + d[1] * d[1]) + (d[2] * d[2] + d[3] * d[3]); }
                q += __shfl_xor(q, 16); q += __shfl_xor(q, 32);
                if (fq == 0) P[(ai * HALF + wr * 64 + m * 16 + fr) * 4 + wc] = (f32x2v){mw, q};
            }
        asm volatile("s_waitcnt lgkmcnt(0)" ::: "memory"); __builtin_amdgcn_s_barrier(); asm volatile("" ::: "memory");
#if defined(BROKEN_EXCHANGE_NO_WAIT)
#warning BROKEN CONTROL BUILD: the row-statistics exchange does not wait; results are wrong by design
        if (blockIdx.x >= 64) { const long long t0_ = clock64(); while (clock64() - t0_ < 60000) __builtin_amdgcn_s_sleep(8); }
#endif
        const int row = wid * 32 + (lane & 31);
        if (lane < 32) {
            const f32x2v a = P[row * 4 + 0], b = P[row * 4 + 1], c = P[row * 4 + 2], d = P[row * 4 + 3];
            const float mt = (a.x + b.x + c.x + d.x) * 0.25f;
            const float da = a.x - mt, db = b.x - mt, dc = c.x - mt, dd = d.x - mt;
            const float m2 = (a.y + b.y) + (c.y + d.y) + 64.0f * ((da * da + db * db) + (dc * dc + dd * dd));
            unsigned long long* slot = (unsigned long long*)xbuf + ((size_t)(u.pm * BM + row) * 4 + u.pn);
            __hip_atomic_store(slot, ((unsigned long long)__float_as_uint(m2) << 32) | __float_as_uint(mt), __ATOMIC_RELAXED, __HIP_MEMORY_SCOPE_AGENT);
        }
        asm volatile("s_waitcnt vmcnt(0)" ::: "memory");
        if (lane == 0) __hip_atomic_fetch_add(cnt + 64 * u.pm, 1u, __ATOMIC_RELAXED, __HIP_MEMORY_SCOPE_AGENT);
        if (wid == 0) {
            bool dead = false; const unsigned long long t0 = __builtin_amdgcn_s_memrealtime(); const unsigned want = 8u * (unsigned)ntn;
            for (;;) {
#if defined(BROKEN_EXCHANGE_NO_WAIT)
                break;
#endif
                if ((unsigned)__builtin_amdgcn_readfirstlane(__hip_atomic_load(cnt + 64 * u.pm, __ATOMIC_RELAXED, __HIP_MEMORY_SCOPE_AGENT)) >= want) break;
                if (__builtin_amdgcn_s_memrealtime() - t0 > 2000000ull) {
                    if (lane == 0) { unsigned expect = 0u; __hip_atomic_compare_exchange_strong(tmo + 1, &expect, code | (unsigned)(u.pm & 0xff), __ATOMIC_RELAXED, __ATOMIC_RELAXED, __HIP_MEMORY_SCOPE_AGENT);
                                     __hip_atomic_store(tmo, 1u, __ATOMIC_RELAXED, __HIP_MEMORY_SCOPE_AGENT); }
                    dead = true; break; }
                __builtin_amdgcn_s_sleep(2);
            }
            __builtin_amdgcn_fence(__ATOMIC_ACQUIRE, "agent");
            if (lane == 0) flag[0] = dead ? 1u : 0u;
        }
        asm volatile("s_waitcnt vmcnt(0) lgkmcnt(0)" ::: "memory"); __builtin_amdgcn_s_barrier(); asm volatile("" ::: "memory");
        const bool bad = flag[0] != 0u;
        if (lane < 32) {
            const unsigned long long* slot = (const unsigned long long*)xbuf + (size_t)(u.pm * BM + row) * 4; float mt[4], m2[4]; float ms = 0.f;
#pragma unroll
            for (int t = 0; t < 4; ++t) { if (t < ntn) { const unsigned long long w = __hip_atomic_load(slot + t, __ATOMIC_RELAXED, __HIP_MEMORY_SCOPE_AGENT); mt[t] = __uint_as_float((unsigned)w); m2[t] = __uint_as_float((unsigned)(w >> 32)); } else { mt[t] = 0.f; m2[t] = 0.f; } ms += mt[t]; }
            const float mean = ms / (float)ntn; float q = 0.f;
#pragma unroll
            for (int t = 0; t < 4; ++t) if (t < ntn) { const float dm = mt[t] - mean; q += m2[t] + 256.0f * dm * dm; }
            S[row] = (f32x2v){mean, 1.0f / sqrtf(q / (256.0f * (float)ntn) + eps)};
        }
        asm volatile("s_waitcnt lgkmcnt(0)" ::: "memory"); __builtin_amdgcn_s_barrier(); asm volatile("" ::: "memory");
        return bad;
    }
};
struct EpiLnRes {
    static constexpr bool PERM = false, AFTER_DRAIN = true;
    const float* base; float* out; int ldc; const float* bias; PanelStats st; unsigned poison;
    __device__ __forceinline__ void fused(f32x4 (&acc)[2][2][4][2], const Unit& u, int wr, int wc, int fr, int fq, PG8_LAS unsigned char* lds, int wid, int lane) const {
        typedef float f32x2v __attribute__((ext_vector_type(2)));
        const PG8_LAS f32x2v* S = (const PG8_LAS f32x2v*)(lds + 8192);
        const int col0 = u.pn * BM + wc * 32 + 4 * fq;
#pragma unroll
        for (int bj = 0; bj < 2; ++bj)
#pragma unroll
            for (int n = 0; n < 2; ++n) { const f32x4 bv = bias ? *(const f32x4*)(bias + col0 + bj * HALF + n * 16) : (f32x4){0.f, 0.f, 0.f, 0.f};
#pragma unroll
                for (int ai = 0; ai < 2; ++ai)
#pragma unroll
                    for (int m = 0; m < 4; ++m) acc[ai][bj][m][n] += bv; }
        f32x4 pre[4][2][2];
#pragma unroll
        for (int m = 0; m < 4; ++m) { const size_t off = (size_t)(u.pm * BM + wr * 64 + m * 16 + fr) * ldc + col0;
#pragma unroll
            for (int bj = 0; bj < 2; ++bj)
#pragma unroll
                for (int n = 0; n < 2; ++n) pre[m][bj][n] = *(const f32x4*)(base + off + bj * HALF + n * 16); }
        const bool bad = st.run(acc, u, wr, wc, fr, fq, lds, wid, lane) || poison != 0u;
        const float qnan = __builtin_nanf("");
#pragma unroll
        for (int ai = 0; ai < 2; ++ai)
#pragma unroll
            for (int m = 0; m < 4; ++m) { const int r = ai * HALF + wr * 64 + m * 16 + fr; const f32x2v sr = S[r]; const size_t off = (size_t)(u.pm * BM + r) * ldc + col0;
#pragma unroll
                for (int bj = 0; bj < 2; ++bj)
#pragma unroll
                    for (int n = 0; n < 2; ++n) { const f32x4 bs = ai == 0 ? pre[m][bj][n] : *(const f32x4*)(base + off + bj * HALF + n * 16); f32x4 o = bs + (acc[ai][bj][m][n] - sr.x) * sr.y;
                        if (bad) o = (f32x4){qnan, qnan, qnan, qnan}; *(f32x4*)(out + off + bj * HALF + n * 16) = o; }
                if (m & 1) asm volatile("" ::: "memory"); }
    }
};
struct EpiLnResLn {
    static constexpr bool PERM = false, AFTER_DRAIN = true;
    const float* base; float* out; bf16_t* xn; int ldc; const float* bias; PanelStats st1, st2; unsigned poison;
    __device__ __forceinline__ void fused(f32x4 (&acc)[2][2][4][2], const Unit& u, int wr, int wc, int fr, int fq, PG8_LAS unsigned char* lds, int wid, int lane) const {
        typedef float f32x2v __attribute__((ext_vector_type(2))); typedef unsigned u32x2v __attribute__((ext_vector_type(2)));
        const PG8_LAS f32x2v* S = (const PG8_LAS f32x2v*)(lds + 8192);
        const int col0 = u.pn * BM + wc * 32 + 4 * fq;
#pragma unroll
        for (int bj = 0; bj < 2; ++bj)
#pragma unroll
            for (int n = 0; n < 2; ++n) { const f32x4 bv = bias ? *(const f32x4*)(bias + col0 + bj * HALF + n * 16) : (f32x4){0.f, 0.f, 0.f, 0.f};
#pragma unroll
                for (int ai = 0; ai < 2; ++ai)
#pragma unroll
                    for (int m = 0; m < 4; ++m) acc[ai][bj][m][n] += bv; }
        bool bad = st1.run(acc, u, wr, wc, fr, fq, lds, wid, lane) || poison != 0u;
        const float qnan = __builtin_nanf("");
#pragma unroll
        for (int ai = 0; ai < 2; ++ai)
#pragma unroll
            for (int m = 0; m < 4; ++m) { const int r = ai * HALF + wr * 64 + m * 16 + fr; const f32x2v sr = S[r]; const size_t off = (size_t)(u.pm * BM + r) * ldc + col0;
#pragma unroll
                for (int bj = 0; bj < 2; ++bj)
#pragma unroll
                    for (int n = 0; n < 2; ++n) { const f32x4 bs = *(const f32x4*)(base + off + bj * HALF + n * 16); acc[ai][bj][m][n] = bs + (acc[ai][bj][m][n] - sr.x) * sr.y; }
                asm volatile("" : "+v"(acc[ai][0][m][0]), "+v"(acc[ai][0][m][1]), "+v"(acc[ai][1][m][0]), "+v"(acc[ai][1][m][1]));
                if (m & 1) asm volatile("" ::: "memory"); }
        const bool bad1 = bad;
        bad = st2.run(acc, u, wr, wc, fr, fq, lds, wid, lane) || bad;
#pragma unroll
        for (int ai = 0; ai < 2; ++ai)
#pragma unroll
            for (int m = 0; m < 4; ++m) { const int r = ai * HALF + wr * 64 + m * 16 + fr; const f32x2v sr = S[r]; const size_t off = (size_t)(u.pm * BM + r) * ldc + col0;
#pragma unroll
                for (int bj = 0; bj < 2; ++bj)
#pragma unroll
                    for (int n = 0; n < 2; ++n) { const f32x4 x1 = acc[ai][bj][m][n]; *(f32x4*)(out + off + bj * HALF + n * 16) = bad1 ? (f32x4){qnan, qnan, qnan, qnan} : x1;
                        const f32x4 o = (x1 - sr.x) * sr.y; u32x2v w; w.x = cvt_pk_bf16(o[0], o[1]); w.y = cvt_pk_bf16(o[2], o[3]);
                        if (bad) { w.x = 0x7fc07fc0u; w.y = 0x7fc07fc0u; } *(u32x2v*)(xn + off + bj * HALF + n * 16) = w; }
                asm volatile("" ::: "memory"); }
    }
};

template <class Epi, class Sched, bool ALIGN_EPI = false, bool SP2 = false>
__device__ __forceinline__ void gemm_phase(PG8_LAS unsigned char* lds, const Gemm g, const Sched& S, const Epi& E) {
    int tid_ = threadIdx.x; asm volatile("" : "+v"(tid_));
    const int tid = tid_, wid = __builtin_amdgcn_readfirstlane(tid >> 6), lane = tid & 63, wr = wid >> 2, wc = wid & 3, fr = lane & 15, fq = lane >> 4;
    const int K = g.K, nt = K / BK;
    unsigned voffA[2], voffB[2];
#pragma unroll
    for (int i = 0; i < 2; ++i) { int R, C; stage_rc(tid * 16 + i * 8192, R, C); const int Rb = Epi::PERM ? ((R & ~31) + perm32(R & 31)) : R;
        voffA[i] = (unsigned)(R * K + C) * 2u; voffB[i] = (unsigned)(Rb * K + C) * 2u; }
    const size_t kstep = (size_t)(BK * 2);
    const size_t hstep = (size_t)HALF * K * 2;
    const size_t tstep = 2 * hstep;
    const unsigned ldsw = (unsigned)wid * 1024u;
    const int aoff = lds_byte(wr * 64 + fr, fq * 8), boff = lds_byte(wc * 32 + fr, fq * 8);
#define PG8_SA(b, h) (((b) * 2 + (h)) * HTB)
#define PG8_SB(b, h) ((4 + (b) * 2 + (h)) * HTB)
#define PG8_STAGE(bufoff, gbase, voff) do { _Pragma("unroll") for (int _i = 0; _i < 2; ++_i) \
        __builtin_amdgcn_global_load_lds((const unsigned*)((const char*)(gbase) + (voff)[_i]), (PG8_LAS unsigned*)(lds + (bufoff) + ldsw + _i * 8192), 16, 0, 0); } while (0)
#define PG8_LDA(dst, b, h) do { _Pragma("unroll") for (int m = 0; m < 4; ++m) _Pragma("unroll") for (int k = 0; k < 2; ++k) dst[m][k] = *(const PG8_LAS bf16x8*)(lds + PG8_SA(b, h) + aoff + m * 2048 + k * 1024); } while (0)
#define PG8_LDB(dst, b, h) do { _Pragma("unroll") for (int n = 0; n < 2; ++n) _Pragma("unroll") for (int k = 0; k < 2; ++k) dst[n][k] = *(const PG8_LAS bf16x8*)(lds + PG8_SB(b, h) + boff + n * 2048 + k * 1024); } while (0)
#define PG8_MMA(ai, bj, At, Bt) do { __builtin_amdgcn_s_setprio(1); _Pragma("unroll") for (int m = 0; m < 4; ++m) _Pragma("unroll") for (int n = 0; n < 2; ++n) _Pragma("unroll") for (int k = 0; k < 2; ++k) \
        acc[ai][bj][m][n] = __builtin_amdgcn_mfma_f32_16x16x32_bf16(Bt[n][k], At[m][k], acc[ai][bj][m][n], 0, 0, 0); __builtin_amdgcn_s_setprio(0); } while (0)
#define PG8_WAIT_V(n) asm volatile("s_waitcnt vmcnt(" #n ")" ::: "memory")
#define PG8_WAIT_L(n) asm volatile("s_waitcnt lgkmcnt(" #n ")" ::: "memory")
#define PG8_BAR __builtin_amdgcn_s_barrier()
#define PG8_SCHED __builtin_amdgcn_sched_barrier(0)
    Unit cur, nxt; int ui = 0;
    if (!S.next(0, cur)) return;
    f32x4 acc[2][2][4][2];
#pragma unroll
    for (int a = 0; a < 2; ++a)
#pragma unroll
        for (int b = 0; b < 2; ++b)
#pragma unroll
            for (int m = 0; m < 4; ++m)
#pragma unroll
                for (int n = 0; n < 2; ++n) acc[a][b][m][n] = (f32x4){0.f, 0.f, 0.f, 0.f};
    bf16x8 At[4][2], B0[2][2], B1[2][2];
    const char* cA = (const char*)g.A + (size_t)cur.pm * tstep; const char* cB = (const char*)g.Bt + (size_t)cur.pn * tstep;
    S.a_ready(cur);
    if constexpr (SP2) {
        PG8_STAGE(PG8_SB(0, 0), cB, voffB); PG8_STAGE(PG8_SB(0, 1), cB + hstep, voffB); PG8_STAGE(PG8_SA(0, 0), cA, voffA); PG8_STAGE(PG8_SA(0, 1), cA + hstep, voffA);
        if (wr == 1) PG8_BAR;
        PG8_WAIT_V(2); PG8_BAR;
        PG8_STAGE(PG8_SB(1, 0), cB + kstep, voffB); PG8_STAGE(PG8_SA(1, 0), cA + kstep, voffA); PG8_STAGE(PG8_SB(1, 1), cB + hstep + kstep, voffB);
        PG8_WAIT_V(6); PG8_BAR;
    } else {
        PG8_STAGE(PG8_SB(0, 0), cB, voffB); PG8_STAGE(PG8_SA(0, 0), cA, voffA); PG8_STAGE(PG8_SB(0, 1), cB + hstep, voffB); PG8_STAGE(PG8_SA(0, 1), cA + hstep, voffA);
        if (wr == 1) PG8_BAR;
        PG8_WAIT_V(4); PG8_BAR;
        PG8_STAGE(PG8_SB(1, 0), cB + kstep, voffB); PG8_STAGE(PG8_SA(1, 0), cA + kstep, voffA); PG8_STAGE(PG8_SB(1, 1), cB + hstep + kstep, voffB);
        PG8_WAIT_V(6); PG8_BAR;
    }
    for (;;) {
        const bool has_next = S.next(ui + 1, nxt);
        const char* nA = has_next ? (const char*)g.A + (size_t)nxt.pm * tstep : cA; const char* nB = has_next ? (const char*)g.Bt + (size_t)nxt.pn * tstep : cB;
        for (int t = 0; t < nt; t += 2) {
            const bool last = (t == nt - 2);
            const char* a1 = cA + (size_t)(t + 1) * kstep;
            const char* a2 = last ? nA : cA + (size_t)(t + 2) * kstep; const char* b2 = last ? nB : cB + (size_t)(t + 2) * kstep;
            const char* a3 = a2 + kstep; const char* b3 = b2 + kstep;
            if (last && has_next) S.a_ready(nxt);
            if constexpr (SP2) {
            PG8_LDB(B0, 0, 0); PG8_LDB(B1, 0, 1); PG8_SCHED; PG8_LDA(At, 0, 0); PG8_STAGE(PG8_SA(1, 1), a1 + hstep, voffA);
            PG8_WAIT_V(8); PG8_WAIT_L(0); PG8_BAR; PG8_MMA(0, 0, At, B0); PG8_MMA(0, 1, At, B1); PG8_BAR; PG8_SCHED;
            PG8_LDA(At, 0, 1); PG8_STAGE(PG8_SB(0, 0), b2, voffB); PG8_STAGE(PG8_SB(0, 1), b2 + hstep, voffB); PG8_STAGE(PG8_SA(0, 0), a2, voffA);
            PG8_WAIT_V(8); PG8_WAIT_L(0); PG8_BAR; PG8_MMA(1, 0, At, B0); PG8_MMA(1, 1, At, B1); PG8_BAR; PG8_SCHED;
            PG8_LDB(B0, 1, 0); PG8_LDB(B1, 1, 1); PG8_SCHED; PG8_LDA(At, 1, 0); PG8_STAGE(PG8_SA(0, 1), a2 + hstep, voffA);
            PG8_WAIT_V(8); PG8_WAIT_L(0); PG8_BAR; PG8_MMA(0, 0, At, B0); PG8_MMA(0, 1, At, B1); PG8_BAR; PG8_SCHED;
            PG8_LDA(At, 1, 1); PG8_STAGE(PG8_SB(1, 0), b3, voffB); PG8_STAGE(PG8_SB(1, 1), b3 + hstep, voffB); PG8_STAGE(PG8_SA(1, 0), a3, voffA);
            PG8_WAIT_V(8); PG8_WAIT_L(0); PG8_BAR; PG8_MMA(1, 0, At, B0); PG8_MMA(1, 1, At, B1); PG8_BAR; PG8_SCHED;
            } else {
            PG8_LDB(B0, 0, 0); PG8_SCHED; PG8_LDA(At, 0, 0); PG8_STAGE(PG8_SA(1, 1), a1 + hstep, voffA);
            PG8_WAIT_L(8); PG8_BAR; PG8_WAIT_L(0); PG8_MMA(0, 0, At, B0); PG8_BAR; PG8_SCHED;
            PG8_LDB(B1, 0, 1); PG8_STAGE(PG8_SB(0, 0), b2, voffB);
            PG8_BAR; PG8_WAIT_L(0); PG8_MMA(0, 1, At, B1); PG8_BAR;
            PG8_LDA(At, 0, 1); PG8_STAGE(PG8_SA(0, 0), a2, voffA);
            PG8_BAR; PG8_WAIT_L(0); PG8_MMA(1, 0, At, B0); PG8_BAR; PG8_SCHED;
            PG8_STAGE(PG8_SB(0, 1), b2 + hstep, voffB);
            PG8_WAIT_V(6); PG8_BAR; PG8_MMA(1, 1, At, B1); PG8_BAR;
            PG8_LDB(B0, 1, 0); PG8_SCHED; PG8_LDA(At, 1, 0); PG8_STAGE(PG8_SA(0, 1), a2 + hstep, voffA);
            PG8_WAIT_L(8); PG8_BAR; PG8_WAIT_L(0); PG8_MMA(0, 0, At, B0); PG8_BAR; PG8_SCHED;
            PG8_LDB(B1, 1, 1); PG8_STAGE(PG8_SB(1, 0), b3, voffB);
            PG8_BAR; PG8_WAIT_L(0); PG8_MMA(0, 1, At, B1); PG8_BAR;
            PG8_LDA(At, 1, 1); PG8_STAGE(PG8_SA(1, 0), a3, voffA);
            PG8_BAR; PG8_WAIT_L(0); PG8_MMA(1, 0, At, B0); PG8_BAR; PG8_SCHED;
            PG8_STAGE(PG8_SB(1, 1), b3 + hstep, voffB);
            PG8_WAIT_V(6); PG8_BAR; PG8_MMA(1, 1, At, B1); PG8_BAR;
            }
        }
        if constexpr (ALIGN_EPI) { if (wr == 0) PG8_BAR; }
        if constexpr (!Epi::AFTER_DRAIN) { E(acc, cur, wr, wc, fr, fq); S.done(cur); }
        if (!has_next) break;
#pragma unroll
        for (int a = 0; a < 2; ++a)
#pragma unroll
            for (int b = 0; b < 2; ++b)
#pragma unroll
                for (int m = 0; m < 4; ++m)
#pragma unroll
                    for (int n = 0; n < 2; ++n) acc[a][b][m][n] = (f32x4){0.f, 0.f, 0.f, 0.f};
        cur = nxt; cA = nA; cB = nB; ++ui;
        if constexpr (ALIGN_EPI) { if (wr == 1) PG8_BAR; }
    }
    PG8_WAIT_V(0);
    if constexpr (!ALIGN_EPI) { if (wr == 0) PG8_BAR; }
    PG8_BAR;
    if constexpr (Epi::AFTER_DRAIN) { E.fused(acc, cur, wr, wc, fr, fq, lds, wid, lane); S.done(cur); }
#undef PG8_SA
#undef PG8_SB
#undef PG8_STAGE
#undef PG8_LDA
#undef PG8_LDB
#undef PG8_MMA
#undef PG8_WAIT_V
#undef PG8_WAIT_L
#undef PG8_BAR
#undef PG8_SCHED
}
}
namespace attn {
using bf16 = __hip_bfloat16;
constexpr int   D = 128, NW = 8, QBLK = 32, KVBLK = 64;
constexpr float SCALE = 0.088388347648318440f;
constexpr float THR = 8.f;
constexpr int SDEPTH = 2;
constexpr int LDQ = 1024, LDK = 256, LDO = 1024;
constexpr size_t SHM_V = KVBLK * D * 2, SHM_K = KVBLK * D * 2, SHM_ATTN = 2 * SHM_V + 2 * SHM_K + NW * 64 * 4;
using bf16x8 = __attribute__((ext_vector_type(8))) short;
using s16x4  = __attribute__((ext_vector_type(4))) short;
using f32x16 = __attribute__((ext_vector_type(16))) float;
using f32x8  = __attribute__((ext_vector_type(8))) float;
using u32x4  = __attribute__((ext_vector_type(4))) unsigned;
#define KSWZ(row, colB) ((row) * 256 + ((colB) ^ (((row) & 7) << 4)))
#define SBAR() __builtin_amdgcn_sched_barrier(0)
__device__ __forceinline__ int crow(int r, int hi) { return (r & 3) + 8 * (r >> 2) + 4 * hi; }
__device__ __forceinline__ unsigned cvtpk(float lo, float hi) {
  unsigned r; asm volatile("v_cvt_pk_bf16_f32 %0, %1, %2" : "=v"(r) : "v"(lo), "v"(hi)); return r;
}
template <typename TIn> struct Stage;
template <> struct Stage<bf16>  { using T = bf16x8;
  __device__ static __forceinline__ T ld8(const bf16* p) { return *reinterpret_cast<const bf16x8*>(p); }
  __device__ static __forceinline__ bf16x8 tobf(T x) { return x; } };
template <> struct Stage<float> { using T = f32x8;
  __device__ static __forceinline__ T ld8(const float* p) { return *reinterpret_cast<const f32x8*>(p); }
  __device__ static __forceinline__ bf16x8 tobf(T x) {
    u32x4 w = {cvtpk(x[0], x[1]), cvtpk(x[2], x[3]), cvtpk(x[4], x[5]), cvtpk(x[6], x[7])}; return *reinterpret_cast<bf16x8*>(&w); } };

__device__ __forceinline__ void partialSM(f32x16& p0, f32x16& p1, float& m_reg, float& mn, float& alpha) {
  constexpr float C = SCALE * 1.4426950408889634f;
  float pmax = p0[0]; for (int r = 1; r < 16; ++r) pmax = fmaxf(pmax, p0[r]); for (int r = 0; r < 16; ++r) pmax = fmaxf(pmax, p1[r]);
  { auto rr = __builtin_amdgcn_permlane32_swap(__float_as_uint(pmax), __float_as_uint(pmax), false, false);
    pmax = fmaxf(__uint_as_float(rr[0]), __uint_as_float(rr[1])); }
  if (__builtin_expect(__all(pmax - m_reg <= THR / SCALE), 1)) { mn = m_reg; alpha = 1.f; }
  else { mn = fmaxf(m_reg, pmax); alpha = __builtin_amdgcn_exp2f((m_reg - mn) * C); m_reg = mn; }
  float mnC = -mn * C;
  for (int r = 0; r < 16; ++r) p0[r] = fmaf(p0[r], C, mnC); for (int r = 0; r < 16; ++r) p1[r] = fmaf(p1[r], C, mnC);
  for (int r = 0; r < 16; ++r) p0[r] = __builtin_amdgcn_exp2f(p0[r]);
}
__device__ __forceinline__ void finishSM(f32x16& p0, f32x16& p1, float alpha, float& l_reg, bf16x8& pa0, bf16x8& pa1, bf16x8& pa2, bf16x8& pa3) {
  for (int r = 0; r < 16; ++r) p1[r] = __builtin_amdgcn_exp2f(p1[r]);
  float ps = 0; for (int r = 0; r < 16; ++r) ps += p0[r]; for (int r = 0; r < 16; ++r) ps += p1[r];
  { auto rr = __builtin_amdgcn_permlane32_swap(__float_as_uint(ps), __float_as_uint(ps), false, false);
    ps = __uint_as_float(rr[0]) + __uint_as_float(rr[1]); }
  l_reg = l_reg * alpha + ps;
#define PK4(P, BASE, OUT) do { unsigned a0 = cvtpk(P[BASE + 0], P[BASE + 1]), a1 = cvtpk(P[BASE + 2], P[BASE + 3]);   \
    unsigned b0 = cvtpk(P[BASE + 4], P[BASE + 5]), b1 = cvtpk(P[BASE + 6], P[BASE + 7]);                              \
    auto r0 = __builtin_amdgcn_permlane32_swap(a0, b0, false, false); auto r1 = __builtin_amdgcn_permlane32_swap(a1, b1, false, false); \
    u32x4 w = {r0[0], r1[0], r0[1], r1[1]}; OUT = *reinterpret_cast<bf16x8*>(&w); } while (0)
  PK4(p0, 0, pa0); PK4(p0, 8, pa1); PK4(p1, 0, pa2); PK4(p1, 8, pa3);
#undef PK4
}
__device__ __forceinline__ void qkt(f32x16& p0, f32x16& p1, const bf16* Ks, const bf16x8* qr, int r32, int hi) {
  p0 = f32x16{}; p1 = f32x16{};
  for (int d0 = 0; d0 < 8; ++d0) { int cb = (d0 * 16 + hi * 8) * 2;
    bf16x8 b0 = *reinterpret_cast<const bf16x8*>((const char*)Ks + KSWZ(r32, cb));
    bf16x8 b1 = *reinterpret_cast<const bf16x8*>((const char*)Ks + KSWZ(32 + r32, cb));
    p0 = __builtin_amdgcn_mfma_f32_32x32x16_bf16(b0, qr[d0], p0, 0, 0, 0);
    p1 = __builtin_amdgcn_mfma_f32_32x32x16_bf16(b1, qr[d0], p1, 0, 0, 0); }
}
__device__ __forceinline__ int v_st(int k, int c) { const int kk = (k & ~0xC) | ((k & 4) << 1) | ((k & 8) >> 1); return ((kk >> 3) * 4 + (c >> 5)) * 512 + ((kk & 7) * 32 + (c & 31)) * 2; }
__device__ __forceinline__ int v_rd_base(int lane) { return ((lane & 3) << 3) | (((lane >> 2) & 3) << 6) | (((lane >> 4) & 1) << 5) | (((lane >> 5) & 1) << 8); }
constexpr int v_rd_off(int d0, int ks, int half) { return d0 * 512 + ks * 4096 + half * 2048; }
template <int OFF> __device__ __forceinline__ s16x4 tr_read(int vb) {
  s16x4 r; asm volatile("ds_read_b64_tr_b16 %0, %1 offset:%2" : "=&v"(r) : "v"(vb), "i"(OFF) : "memory"); return r;
}
template <int D0> __device__ __forceinline__ void pv_one(f32x16& od, int vb, bf16x8 pa0, bf16x8 pa1, bf16x8 pa2, bf16x8 pa3) {
  const s16x4 l0 = tr_read<v_rd_off(D0, 0, 0)>(vb), h0 = tr_read<v_rd_off(D0, 0, 1)>(vb), l1 = tr_read<v_rd_off(D0, 1, 0)>(vb), h1 = tr_read<v_rd_off(D0, 1, 1)>(vb);
  const s16x4 l2 = tr_read<v_rd_off(D0, 2, 0)>(vb), h2 = tr_read<v_rd_off(D0, 2, 1)>(vb), l3 = tr_read<v_rd_off(D0, 3, 0)>(vb), h3 = tr_read<v_rd_off(D0, 3, 1)>(vb);
  asm volatile("s_waitcnt lgkmcnt(0)" ::: "memory"); SBAR();
#define PK(L, H) (bf16x8){L[0], L[1], L[2], L[3], H[0], H[1], H[2], H[3]}
  od = __builtin_amdgcn_mfma_f32_32x32x16_bf16(pa0, PK(l0, h0), od, 0, 0, 0);
  od = __builtin_amdgcn_mfma_f32_32x32x16_bf16(pa1, PK(l1, h1), od, 0, 0, 0);
  od = __builtin_amdgcn_mfma_f32_32x32x16_bf16(pa2, PK(l2, h2), od, 0, 0, 0);
  od = __builtin_amdgcn_mfma_f32_32x32x16_bf16(pa3, PK(l3, h3), od, 0, 0, 0);
#undef PK
}
__device__ __forceinline__ void pv_d0(f32x16* o, int vb, bf16x8 pa0, bf16x8 pa1, bf16x8 pa2, bf16x8 pa3) {
  pv_one<0>(o[0], vb, pa0, pa1, pa2, pa3); pv_one<1>(o[1], vb, pa0, pa1, pa2, pa3); pv_one<2>(o[2], vb, pa0, pa1, pa2, pa3); pv_one<3>(o[3], vb, pa0, pa1, pa2, pa3);
}

template <typename TQ>
__device__ __forceinline__ void attn_dense_body(const TQ* __restrict__ Qb, const bf16* __restrict__ Kh, const bf16* __restrict__ Vh,
                                                unsigned short* Ob, int seq, char* lds, const float* __restrict__ qgain, const float* __restrict__ cs_tab, const float* __restrict__ sn_tab) {
  using St = Stage<bf16>; using SQ = Stage<TQ>;
  int tid_ = threadIdx.x; asm volatile("" : "+v"(tid_));
  const int tid = tid_, wid = tid >> 6, lane = tid & 63, r32 = lane & 31, hi = lane >> 5;
  bf16* V_lds = (bf16*)lds; bf16* K_lds = (bf16*)(lds + 2 * SHM_V);
  float* ws = (float*)(lds + 2 * SHM_V + 2 * SHM_K) + wid * 64; float* li_l = ws; float* al_l = ws + 32;
  float m_reg = -1e30f, l_reg = 0; f32x16 o[4] = {}; bf16x8 qr[8];
  const TQ* Qw = Qb + (long)(wid * QBLK + r32) * LDQ + hi * 8;
  { float xq[8][8]; float ss = 0.f;
#pragma unroll
    for (int d0 = 0; d0 < 8; ++d0) { const u32x4 w = *reinterpret_cast<const u32x4*>(Qw + d0 * 16);
#pragma unroll
      for (int e2 = 0; e2 < 4; ++e2) { xq[d0][2 * e2] = __uint_as_float(w[e2] << 16); xq[d0][2 * e2 + 1] = __uint_as_float(w[e2] & 0xffff0000u); }
#pragma unroll
      for (int e = 0; e < 8; ++e) ss += xq[d0][e] * xq[d0][e]; }
    ss += __shfl_xor(ss, 32);
    const float rn = 1.f / sqrtf(ss * (1.f / 128.f) + 1e-6f);
#pragma unroll
    for (int d0 = 0; d0 < 8; ++d0) { const f32x8 g8 = *reinterpret_cast<const f32x8*>(qgain + d0 * 16 + hi * 8);
#pragma unroll
      for (int e = 0; e < 8; ++e) xq[d0][e] *= rn * g8[e]; }
    if (cs_tab) {
      const long trow = (long)(wid * QBLK + r32) * 64;
#pragma unroll
      for (int ax = 0; ax < 2; ++ax)
#pragma unroll
        for (int lo = 0; lo < 2; ++lo) { const int d1 = 4 * ax + lo, d2 = d1 + 2, p0 = lo * 16 + hi * 8;
          const f32x8 c8 = *reinterpret_cast<const f32x8*>(cs_tab + trow + ax * 32 + p0), s8 = *reinterpret_cast<const f32x8*>(sn_tab + trow + ax * 32 + p0);
#pragma unroll
          for (int e = 0; e < 8; ++e) { const float x1 = xq[d1][e], x2 = xq[d2][e]; xq[d1][e] = x1 * c8[e] - x2 * s8[e]; xq[d2][e] = x2 * c8[e] + x1 * s8[e]; } }
    }
#pragma unroll
    for (int d0 = 0; d0 < 8; ++d0) { u32x4 w = {cvtpk(xq[d0][0], xq[d0][1]), cvtpk(xq[d0][2], xq[d0][3]), cvtpk(xq[d0][4], xq[d0][5]), cvtpk(xq[d0][6], xq[d0][7])}; qr[d0] = *reinterpret_cast<bf16x8*>(&w); }
  }
  const int sr = tid >> 4, sc = (tid & 15) * 8, vst0 = v_st(sr, sc), vst1 = v_st(32 + sr, sc);
  const int vb0 = (int)(uintptr_t)V_lds + v_rd_base(lane);
  struct { typename St::T vs0, vs1, ks0, ks1; } sr_[SDEPTH];
  const int goff0 = sr * LDK + sc, goff1 = (32 + sr) * LDK + sc;
#define SLOAD(i, k0) do { const bf16* vb_ = Vh + (long)(k0) * LDK; const bf16* kb_ = Kh + (long)(k0) * LDK; \
    sr_[i].vs0 = St::ld8(vb_ + goff0); sr_[i].vs1 = St::ld8(vb_ + goff1); sr_[i].ks0 = St::ld8(kb_ + goff0); sr_[i].ks1 = St::ld8(kb_ + goff1); } while (0)
#define SWRITE(b, i) do { *(bf16x8*)((char*)V_lds + (b) * SHM_V + vst0) = St::tobf(sr_[i].vs0);          \
    *(bf16x8*)((char*)V_lds + (b) * SHM_V + vst1) = St::tobf(sr_[i].vs1); int kc = sc * 2;               \
    *(bf16x8*)((char*)K_lds + (b) * SHM_K + KSWZ(sr, kc)) = St::tobf(sr_[i].ks0);                       \
    *(bf16x8*)((char*)K_lds + (b) * SHM_K + KSWZ(32 + sr, kc)) = St::tobf(sr_[i].ks1); } while (0)
#define SWAIT() do { if constexpr (SDEPTH == 2) asm volatile("s_waitcnt vmcnt(4)" ::: "memory"); else asm volatile("s_waitcnt vmcnt(0)" ::: "memory"); } while (0)
#define RESC(a) do { if (__any((a) < 1.f)) { if (hi == 0) al_l[r32] = (a); asm volatile("s_waitcnt lgkmcnt(0)" ::: "memory"); \
    for (int d = 0; d < 4; ++d) for (int r = 0; r < 16; ++r) o[d][r] *= al_l[crow(r, hi)]; } } while (0)
  f32x16 pA0, pA1, pB0, pB1; float mnA, mnB, alA, alB; bf16x8 pa0, pa1, pa2, pa3; const int NT = seq / KVBLK;
  constexpr int SE = 0, SO = SDEPTH - 1;
  SLOAD(SE, 0); asm volatile("s_waitcnt vmcnt(0)" ::: "memory"); SWRITE(0, SE); __syncthreads();
  qkt(pA0, pA1, K_lds, qr, r32, hi); partialSM(pA0, pA1, m_reg, mnA, alA);
  SLOAD(SO, KVBLK); if constexpr (SDEPTH == 2) { if (2 < NT) SLOAD(SE, 2 * KVBLK); }
  SWAIT(); SWRITE(1, SO); __syncthreads();
  for (int j = 1; j + 1 < NT; j += 2) {
    SBAR(); qkt(pB0, pB1, (bf16*)((char*)K_lds + SHM_K), qr, r32, hi);
    finishSM(pA0, pA1, alA, l_reg, pa0, pa1, pa2, pa3); SBAR();
    SLOAD(SO, (j + SDEPTH) * KVBLK); SBAR();
    pv_d0(o, vb0, pa0, pa1, pa2, pa3); partialSM(pB0, pB1, m_reg, mnB, alB);
    __syncthreads(); SWAIT(); SWRITE(0, SE);
    RESC(alB); __syncthreads();
    SBAR(); qkt(pA0, pA1, K_lds, qr, r32, hi);
    finishSM(pB0, pB1, alB, l_reg, pa0, pa1, pa2, pa3); SBAR();
    if (SDEPTH == 1 || j + 3 < NT) SLOAD(SE, (j + 1 + SDEPTH) * KVBLK); SBAR();
    pv_d0(o, vb0 + (int)SHM_V, pa0, pa1, pa2, pa3); partialSM(pA0, pA1, m_reg, mnA, alA);
    __syncthreads(); SWAIT(); SWRITE(1, SO);
    RESC(alA); __syncthreads();
  }
  SBAR(); qkt(pB0, pB1, (bf16*)((char*)K_lds + SHM_K), qr, r32, hi);
  finishSM(pA0, pA1, alA, l_reg, pa0, pa1, pa2, pa3); SBAR();
  pv_d0(o, vb0, pa0, pa1, pa2, pa3); partialSM(pB0, pB1, m_reg, mnB, alB);
  __syncthreads(); RESC(alB);
  finishSM(pB0, pB1, alB, l_reg, pa0, pa1, pa2, pa3); SBAR();
  pv_d0(o, vb0 + (int)SHM_V, pa0, pa1, pa2, pa3);
  if (hi == 0) li_l[r32] = l_reg; asm volatile("s_waitcnt lgkmcnt(0)" ::: "memory");
  float rli[16];
#pragma unroll
  for (int r = 0; r < 16; ++r) rli[r] = __builtin_amdgcn_rcpf(li_l[crow(r, hi)]);
  unsigned short* Ow = Ob + (long)(wid * QBLK) * LDO;
#pragma unroll
  for (int r = 0; r < 16; ++r) { int orow = crow(r, hi);
    for (int d0 = 0; d0 < 4; ++d0) Ow[(long)orow * LDO + d0 * 32 + r32] = (unsigned short)(cvtpk(o[d0][r] * rli[r], 0.f) & 0xffffu); }
#undef SLOAD
#undef SWRITE
#undef SWAIT
#undef RESC
}
#undef KSWZ
#undef SBAR
}
#define GAS __attribute__((address_space(1)))
#define LAS __attribute__((address_space(3)))
typedef unsigned short bf16_t;
typedef unsigned v4u __attribute__((ext_vector_type(4)));
typedef unsigned v2u __attribute__((ext_vector_type(2)));
typedef float f32x4 __attribute__((ext_vector_type(4)));
typedef float f32x16 __attribute__((ext_vector_type(16)));
typedef short bf16x8 __attribute__((ext_vector_type(8)));
typedef short bf16x4 __attribute__((ext_vector_type(4)));

constexpr int DM = 1024, NB = 32, SEQ = 2048, CTXL = 256;
constexpr int ML = NB * SEQ, MC = NB * CTXL, MT = ML + MC;
constexpr int DFF = 2816, NFF1 = 2 * DFF;
constexpr int NMODC = 9 * DM;
constexpr int KVS = SEQ + CTXL;
constexpr int NQKV = 1536, NMLIN = 3088, NMLPAD = 3328, PLD = 3072;
constexpr float ALPHA = 1.41421356237309515f;
constexpr float LN_EPS = 1e-5f, RMS_EPS = 1e-6f;
constexpr int NWAVES = 8, NTHR = 512;
constexpr int LDS_BYTES = 132096;

constexpr size_t MiB = 1u << 20;
constexpr size_t WS_CTL = 0;
constexpr size_t WS_STATS = 1 * MiB;
constexpr size_t WS_W1 = 4 * MiB;
constexpr size_t W1_SZ = (size_t)NFF1 * DM * 2;
constexpr size_t WS_W2 = WS_W1 + 4 * W1_SZ;
constexpr size_t W2_SZ = (size_t)DM * DFF * 2;
constexpr size_t WS_WQKV = WS_W2 + 4 * W2_SZ;
constexpr size_t WS_WOA = WS_WQKV + (size_t)NQKV * DM * 2;
constexpr size_t WS_WMI = WS_WOA + (size_t)DM * DM * 2;
constexpr size_t WS_WMO = WS_WMI + (size_t)NMLPAD * DM * 2;
constexpr size_t WS_WEND = WS_WMO + (size_t)DM * DM * 2;
static_assert(WS_WEND <= 92 * MiB, "weights");
constexpr size_t WS_MOD = 92 * MiB;
constexpr size_t WS_ROPE = 95 * MiB;
constexpr size_t WS_H = 96 * MiB;
constexpr size_t WS_XM = 384 * MiB;
constexpr size_t WS_BIG = 528 * MiB;
constexpr size_t WS_Q = WS_BIG, WS_K = WS_BIG + 144 * MiB, WS_V = WS_K + 36 * MiB;
constexpr size_t WS_G = 960 * MiB;
constexpr size_t WS_END = 966 * MiB;

using attn::cvtpk;
__device__ __forceinline__ float bflo(unsigned w) { return __uint_as_float(w << 16); }
__device__ __forceinline__ float bfhi(unsigned w) { return __uint_as_float(w & 0xffff0000u); }
__device__ __forceinline__ float siluf(float a) { return a * __builtin_amdgcn_rcpf(1.f + __expf(-a)); }
__device__ __forceinline__ float wave_sum(float v) {
#pragma unroll
    for (int o = 1; o < 64; o <<= 1) v += __shfl_xor(v, o);
    return v;
}
#define LDS_WAIT() asm volatile("s_waitcnt lgkmcnt(0)" ::: "memory")

struct EpiSwiglu {
    static constexpr bool PERM = true, AFTER_DRAIN = false;
    bf16_t* O;
    __device__ __forceinline__ void operator()(const pg8::f32x4 (&acc)[2][2][4][2], const pg8::Unit& u, int wr, int wc, int fr, int fq) const {
        const int row0 = u.pm * 256 + wr * 64 + fr, col0 = u.pn * 128 + wc * 32 + 8 * fq;
#pragma unroll
        for (int ai = 0; ai < 2; ++ai)
#pragma unroll
            for (int m = 0; m < 4; ++m) {
                bf16_t* rowp = O + (size_t)(row0 + ai * 128 + m * 16) * DFF + col0;
                const pg8::f32x4 a0 = acc[ai][0][m][0], a1 = acc[ai][0][m][1], u0 = acc[ai][1][m][0], u1 = acc[ai][1][m][1];
                v4u w;
                w.x = cvtpk(siluf(a0[0]) * u0[0], siluf(a0[1]) * u0[1]); w.y = cvtpk(siluf(a0[2]) * u0[2], siluf(a0[3]) * u0[3]);
                w.z = cvtpk(siluf(a1[0]) * u1[0], siluf(a1[1]) * u1[1]); w.w = cvtpk(siluf(a1[2]) * u1[2], siluf(a1[3]) * u1[3]);
                *(v4u*)rowp = w;
            }
    }
};
typedef _Float16 h16x8 __attribute__((ext_vector_type(8)));
template <bool LNRES, int GS2> struct EpiResid {
    static constexpr bool PERM = true, AFTER_DRAIN = false;
    const float* res_lat; const float* res_ctx; _Float16* Z; const float* gate; const float* stats; const float* lg; const float* lb;
    __device__ __forceinline__ void operator()(const pg8::f32x4 (&acc)[2][2][4][2], const pg8::Unit& u, int wr, int wc, int fr, int fq) const {
        const int r0 = u.pm * 256, row0 = r0 + wr * 64 + fr;
        const int bi = r0 < ML ? (r0 >> 11) : NB;
#pragma unroll
        for (int bj = 0; bj < 2; ++bj) {
            const int c = u.pn * 256 + bj * 128 + wc * 32 + 8 * fq;
            const pg8::f32x4 gv0 = *(const pg8::f32x4*)(gate + (size_t)bi * NMODC + c) * (0.5f * GS2), gv1 = *(const pg8::f32x4*)(gate + (size_t)bi * NMODC + c + 4) * (0.5f * GS2);
            pg8::f32x4 g0 = {1.f, 1.f, 1.f, 1.f}, g1 = g0, b0 = {0.f, 0.f, 0.f, 0.f}, b1 = b0;
            if (LNRES) { g0 = *(const pg8::f32x4*)(lg + c); g1 = *(const pg8::f32x4*)(lg + c + 4); b0 = *(const pg8::f32x4*)(lb + c); b1 = *(const pg8::f32x4*)(lb + c + 4); }
#pragma unroll
            for (int ai = 0; ai < 2; ++ai)
#pragma unroll
                for (int m = 0; m < 4; ++m) {
                    const int row = row0 + ai * 128 + m * 16;
                    pg8::f32x4 ra, rb;
                    if (LNRES) { const h16x8 zz = *(const h16x8*)(Z + (size_t)row * DM + c); const float mean = stats[2 * row], rstd = stats[2 * row + 1];
                        ra = (pg8::f32x4){(float)zz[0], (float)zz[1], (float)zz[2], (float)zz[3]}; rb = (pg8::f32x4){(float)zz[4], (float)zz[5], (float)zz[6], (float)zz[7]};
                        ra = (ra - mean) * rstd * g0 + b0; rb = (rb - mean) * rstd * g1 + b1; }
                    else { const float* rp = (row < ML ? res_lat + (size_t)row * DM : res_ctx + (size_t)(row - ML) * DM) + c; ra = *(const pg8::f32x4*)rp; rb = *(const pg8::f32x4*)(rp + 4); }
                    const pg8::f32x4 oa = ra * ALPHA + gv0 * acc[ai][bj][m][0], ob = rb * ALPHA + gv1 * acc[ai][bj][m][1];
                    h16x8 o; o[0] = (_Float16)oa[0]; o[1] = (_Float16)oa[1]; o[2] = (_Float16)oa[2]; o[3] = (_Float16)oa[3]; o[4] = (_Float16)ob[0]; o[5] = (_Float16)ob[1]; o[6] = (_Float16)ob[2]; o[7] = (_Float16)ob[3];
                    *(h16x8*)(Z + (size_t)row * DM + c) = o;
                }
        }
    }
};
struct EpiQKV {
    static constexpr bool PERM = true, AFTER_DRAIN = false;
    bf16_t* Q; bf16_t* Kb; bf16_t* Vb;
    __device__ __forceinline__ void operator()(const pg8::f32x4 (&acc)[2][2][4][2], const pg8::Unit& u, int wr, int wc, int fr, int fq) const {
        const int r0 = u.pm * 256; bf16_t* base; int ld;
        if (u.pn < 4) { base = Q + (size_t)r0 * DM + u.pn * 256; ld = DM; }
        else { const int kvr = r0 < ML ? (r0 >> 11) * KVS + (r0 & 2047) : ((r0 - ML) >> 8) * KVS + SEQ + ((r0 - ML) & 255);
               base = (u.pn == 4 ? Kb : Vb) + (size_t)kvr * 256; ld = 256; }
        const int rl = wr * 64 + fr, col0 = wc * 32 + 8 * fq;
#pragma unroll
        for (int ai = 0; ai < 2; ++ai)
#pragma unroll
            for (int m = 0; m < 4; ++m) {
                bf16_t* rowp = base + (size_t)(rl + ai * 128 + m * 16) * ld + col0;
#pragma unroll
                for (int bj = 0; bj < 2; ++bj) { const pg8::f32x4 v0 = acc[ai][bj][m][0], v1 = acc[ai][bj][m][1];
                    v4u w; w.x = cvtpk(v0[0], v0[1]); w.y = cvtpk(v0[2], v0[3]); w.z = cvtpk(v1[0], v1[1]); w.w = cvtpk(v1[2], v1[3]);
                    *(v4u*)(rowp + bj * 128) = w; }
            }
    }
};
struct EpiMlIn {
    static constexpr bool PERM = true, AFTER_DRAIN = false;
    bf16_t* P; float* G; const float* gate_b;
    __device__ __forceinline__ void operator()(const pg8::f32x4 (&acc)[2][2][4][2], const pg8::Unit& u, int wr, int wc, int fr, int fq) const {
        const int row0 = u.pm * 256 + wr * 64 + fr;
        if (u.pn < 12) {
            const int col0 = u.pn * 256 + wc * 32 + 8 * fq;
#pragma unroll
            for (int ai = 0; ai < 2; ++ai)
#pragma unroll
                for (int m = 0; m < 4; ++m) {
                    bf16_t* rowp = P + (size_t)(row0 + ai * 128 + m * 16) * PLD + col0;
#pragma unroll
                    for (int bj = 0; bj < 2; ++bj) { const pg8::f32x4 v0 = acc[ai][bj][m][0], v1 = acc[ai][bj][m][1];
                        v4u w; w.x = cvtpk(v0[0], v0[1]); w.y = cvtpk(v0[2], v0[3]); w.z = cvtpk(v1[0], v1[1]); w.w = cvtpk(v1[2], v1[3]);
                        *(v4u*)(rowp + bj * 128) = w; }
                }
        } else if (wc == 0 && fq < 2) {
            const pg8::f32x4 b0 = *(const pg8::f32x4*)(gate_b + 8 * fq), b1 = *(const pg8::f32x4*)(gate_b + 8 * fq + 4);
#pragma unroll
            for (int ai = 0; ai < 2; ++ai)
#pragma unroll
                for (int m = 0; m < 4; ++m) {
                    float* gp = G + (size_t)(row0 + ai * 128 + m * 16) * 16 + 8 * fq;
                    *(pg8::f32x4*)gp = acc[ai][0][m][0] + b0; *(pg8::f32x4*)(gp + 4) = acc[ai][0][m][1] + b1;
                }
        }
    }
};

typedef GAS unsigned gu32;
constexpr int XB_LDS_OFF = 131072;
#define XB_TMO      128
#define XB_XCNT(j)  (256  + 64 * (j))
#define XB_XSUB(j)  (1280 + 64 * (j))
#define XB_XGEN(j)  (2304 + 64 * (j))
#define XB_TOP      3328
#define XB_TOPGEN   3392
#define XCD_BAR_WORDS 3456
#define XB_SPIN_CAP (1u << 18)

__device__ __forceinline__ unsigned xb_ld(unsigned* p)              { return __hip_atomic_load(p, __ATOMIC_RELAXED, __HIP_MEMORY_SCOPE_AGENT); }
__device__ __forceinline__ unsigned xb_add(unsigned* p, unsigned v) { return __hip_atomic_fetch_add(p, v, __ATOMIC_RELAXED, __HIP_MEMORY_SCOPE_AGENT); }
__device__ __forceinline__ unsigned xb_xcc_id() { return (unsigned)__builtin_amdgcn_s_getreg((3 << 11) | 20) & 0xFu; }
#define XB_SPIN(cond, bar) do { unsigned _sp = 0; while (cond) { __builtin_amdgcn_s_sleep(1); \
    if ((++_sp & 255u) == 0u) { if (xb_ld(&(bar)[XB_TMO])) break; if (_sp > XB_SPIN_CAP) { atomicAdd(&(bar)[XB_TMO], 1u); break; } } } } while (0)

struct XcdBarrier {
    unsigned* bar; unsigned x;
    volatile LAS unsigned* st;
};

__device__ __forceinline__ XcdBarrier xcd_barrier_post(unsigned* bar, volatile LAS unsigned* st) {
    XcdBarrier b; b.bar = bar; b.x = xb_xcc_id(); b.st = st;
    if (threadIdx.x == 0) (void)xb_add(&bar[XB_XCNT(b.x)], 1u);
    return b;
}
__device__ __forceinline__ void xcd_barrier_complete(unsigned* bar, unsigned x, unsigned& nloc, unsigned& nx) {
    const unsigned G = gridDim.x * gridDim.y * gridDim.z;
    unsigned sum, cnt, mine, sp = 0u;
    for (;;) {
        sum = 0u; cnt = 0u; mine = 0u;
#pragma unroll
        for (unsigned j = 0; j < 16; ++j) { const unsigned c = xb_ld(&bar[XB_XCNT(j)]); sum += c; cnt += (c > 0u) ? 1u : 0u; mine = (j == x) ? c : mine; }
        if (sum == G) break;
        __builtin_amdgcn_s_sleep(1);
        if ((++sp & 255u) == 0u) { if (xb_ld(&bar[XB_TMO])) break; if (sp > XB_SPIN_CAP) { atomicAdd(&bar[XB_TMO], 1u); break; } }
    }
    nloc = mine > 0u ? mine : 1u; nx = cnt > 0u ? cnt : 1u;
}

__device__ __forceinline__ void xcd_barrier(const XcdBarrier& b) {
    asm volatile("s_waitcnt vmcnt(0)" ::: "memory");
    __syncthreads();
    if (threadIdx.x == 0) {
        unsigned* bar = b.bar;
        __builtin_amdgcn_s_waitcnt(0);
        unsigned nloc = b.st[0], nx = b.st[1];
        if (nloc == 0u) { xcd_barrier_complete(bar, b.x, nloc, nx); b.st[0] = nloc; b.st[1] = nx; }
        const unsigned old = xb_add(&bar[XB_XSUB(b.x)], 1u);
        const unsigned gen = old / nloc;
        if (old + 1u == (gen + 1u) * nloc) {
            __builtin_amdgcn_fence(__ATOMIC_RELEASE, "agent");
            asm volatile("s_waitcnt vmcnt(0)" ::: "memory");
            const unsigned og = xb_add(&bar[XB_TOP], 1u);
            const unsigned tg = og / nx;
            if (og + 1u == (tg + 1u) * nx) xb_add(&bar[XB_TOPGEN], 1u);
            else XB_SPIN(xb_ld(&bar[XB_TOPGEN]) == tg, bar);
            __builtin_amdgcn_fence(__ATOMIC_ACQUIRE, "agent");
            xb_add(&bar[XB_XGEN(b.x)], 1u);
            asm volatile("s_waitcnt vmcnt(0)" ::: "memory");
        } else {
            XB_SPIN(xb_ld(&bar[XB_XGEN(b.x)]) == gen, bar);
            __builtin_amdgcn_fence(__ATOMIC_ACQUIRE, "agent");
            asm volatile("s_waitcnt vmcnt(0)" ::: "memory");
        }
    }
    __syncthreads();
}


struct Args { const float* in[20]; float* out; unsigned char* ws; int ph_lo, ph_hi; };
struct Ctx {
    LAS unsigned char* lds; char* ldsg;
    int tid, lane, wave, G, bid;
    float* out; unsigned char* ws;
};
__device__ __forceinline__ unsigned long long karg_u64(int byte_off) {
    unsigned long long base = (unsigned long long)__builtin_amdgcn_kernarg_segment_ptr(); asm volatile("" : "+s"(base));
    return *(const __attribute__((address_space(4))) unsigned long long*)(base + byte_off);
}
#define ARG_IN(i) ((const float*)(const GAS float*)karg_u64(8 * (i)))
__device__ __forceinline__ void relane(Ctx& F) {
    int t_ = threadIdx.x; asm volatile("" : "+v"(t_)); F.tid = t_; F.lane = t_ & 63; F.wave = __builtin_amdgcn_readfirstlane(t_ >> 6);
    int b_ = blockIdx.x, g_ = gridDim.x; asm volatile("" : "+s"(b_), "+s"(g_)); F.bid = b_; F.G = g_;
    F.out = (float*)(GAS float*)karg_u64(160); F.ws = (unsigned char*)(GAS unsigned char*)karg_u64(168);
}
__device__ __forceinline__ void transpose_item(const float* __restrict__ W, int K, int N, bf16_t* WT, int k0, int n0, int drow0, LAS float* scr, int lane) {
    const int nq = (lane & 7) * 4, kr = lane >> 3;
    const bool ok = n0 + nq < N;
    f32x4 t[8];
#pragma unroll
    for (int i = 0; i < 8; ++i) t[i] = ok ? *(const f32x4*)(W + (size_t)(k0 + 8 * i + kr) * N + n0 + nq) : (f32x4){0.f, 0.f, 0.f, 0.f};
#pragma unroll
    for (int i = 0; i < 8; ++i) { LAS float* d = scr + (8 * i + kr) * 33 + nq; d[0] = t[i][0]; d[1] = t[i][1]; d[2] = t[i][2]; d[3] = t[i][3]; }
    LDS_WAIT(); asm volatile("" ::: "memory");
    const int c = lane & 7;
#pragma unroll
    for (int j = 0; j < 4; ++j) { const int n = (lane >> 3) + 8 * j; const LAS float* s = scr + (8 * c) * 33 + n;
        v4u o; o.x = cvtpk(s[0 * 33], s[1 * 33]); o.y = cvtpk(s[2 * 33], s[3 * 33]); o.z = cvtpk(s[4 * 33], s[5 * 33]); o.w = cvtpk(s[6 * 33], s[7 * 33]);
        *(v4u*)(WT + (size_t)(drow0 + n) * K + k0 + 8 * c) = o; }
    LDS_WAIT(); asm volatile("" ::: "memory");
}
__device__ __forceinline__ void p0_weights(Ctx& F, const float* w_ffn_in, const float* w_ffn_out, const float* w_att_in, const float* w_att_out, const float* w_ml_in, const float* w_ml_out) {
    LAS float* scr = (LAS float*)(F.lds + F.wave * 8448);
    const int nlight = F.G >= 64 ? 32 : 0;
    const int gw = F.bid < nlight ? (F.wave < 4 ? F.bid * 4 + F.wave : -1) : nlight * 4 + (F.bid - nlight) * NWAVES + F.wave, NGW = nlight * 4 + (F.G - nlight) * NWAVES;
    constexpr int I_W1 = 16 * (NFF1 / 32), I_W2 = (DFF / 64) * (DM / 32), I_QKV = 16 * (NQKV / 32), I_O = 16 * 32, I_MI = 16 * (NMLPAD / 32);
    constexpr int NITEMS = 4 * I_W1 + 4 * I_W2 + I_QKV + I_O + I_MI + I_O;
    for (int it = gw < 0 ? NITEMS : gw; it < NITEMS; it += NGW) {
        int r = it; const float* src; bf16_t* dst; int K, N, nblk, mode = 0;
        if (r < 4 * I_W1) { const int mi = r / I_W1; r -= mi * I_W1; src = w_ffn_in + (size_t)mi * DM * NFF1; dst = (bf16_t*)(F.ws + WS_W1 + mi * W1_SZ); K = DM; N = NFF1; nblk = NFF1 / 32; mode = 1; }
        else if ((r -= 4 * I_W1) < 4 * I_W2) { const int mi = r / I_W2; r -= mi * I_W2; src = w_ffn_out + (size_t)mi * DFF * DM; dst = (bf16_t*)(F.ws + WS_W2 + mi * W2_SZ); K = DFF; N = DM; nblk = DM / 32; }
        else if ((r -= 4 * I_W2) < I_QKV) { src = w_att_in; dst = (bf16_t*)(F.ws + WS_WQKV); K = DM; N = NQKV; nblk = NQKV / 32; }
        else if ((r -= I_QKV) < I_O) { src = w_att_out; dst = (bf16_t*)(F.ws + WS_WOA); K = DM; N = DM; nblk = DM / 32; }
        else if ((r -= I_O) < I_MI) { src = w_ml_in; dst = (bf16_t*)(F.ws + WS_WMI); K = DM; N = NMLIN; nblk = NMLPAD / 32; }
        else { r -= I_MI; src = w_ml_out; dst = (bf16_t*)(F.ws + WS_WMO); K = DM; N = DM; nblk = DM / 32; }
        const int kb = r / nblk, nb = r - kb * nblk, n0 = 32 * nb;
        int drow = n0;
        if (mode == 1) { const int j0 = n0 < DFF ? n0 : n0 - DFF; drow = 256 * (j0 >> 7) + (j0 & 127) + (n0 < DFF ? 0 : 128); }
        transpose_item(src, K, N, dst, 64 * kb, n0, drow, scr, F.lane);
    }
}
__device__ __forceinline__ void p0_mods(Ctx& F, const float* c, const float* cctx, const float* ada_w, const float* ada_b) {
    float* MOD = (float*)(F.ws + WS_MOD);
    LAS float* sv = (LAS float*)(F.lds + 0) + F.wave * (33 * 32);
    LAS float* red = (LAS float*)(F.lds + 8 * 33 * 32 * 4);
    for (int task = F.bid; task < 2 * (NMODC / 64); task += F.G) {
        const int l = task / (NMODC / 64), n0 = (task % (NMODC / 64)) * 64;
        const float* Wl = ada_w + (size_t)l * DM * NMODC + n0 + F.lane;
        float acc[33];
#pragma unroll
        for (int b = 0; b < 33; ++b) acc[b] = 0.f;
        for (int sub = 0; sub < 4; ++sub) {
            const int k0 = F.wave * 128 + sub * 32;
            for (int idx = F.lane; idx < 33 * 32; idx += 64) { const int b = idx >> 5, kk = idx & 31; const float cv = b < 32 ? c[b * DM + k0 + kk] : cctx[k0 + kk];
                sv[idx] = cv / (1.f + expf(-cv)); }
            LDS_WAIT(); asm volatile("" ::: "memory");
            float n0_ = Wl[(size_t)(k0 + 0) * NMODC], n1_ = Wl[(size_t)(k0 + 1) * NMODC], n2_ = Wl[(size_t)(k0 + 2) * NMODC], n3_ = Wl[(size_t)(k0 + 3) * NMODC];
#pragma unroll 1
            for (int k4 = 0; k4 < 8; ++k4) {
                const float w0 = n0_, w1 = n1_, w2 = n2_, w3 = n3_;
                const int kn = k0 + (k4 < 7 ? 4 * k4 + 4 : 0);
                n0_ = Wl[(size_t)(kn + 0) * NMODC]; n1_ = Wl[(size_t)(kn + 1) * NMODC]; n2_ = Wl[(size_t)(kn + 2) * NMODC]; n3_ = Wl[(size_t)(kn + 3) * NMODC];
#pragma unroll
                for (int b = 0; b < 33; ++b) { const f32x4 s4 = *(const LAS f32x4*)(sv + b * 32 + 4 * k4); acc[b] += s4[0] * w0 + s4[1] * w1 + s4[2] * w2 + s4[3] * w3; }
            }
            LDS_WAIT(); asm volatile("" ::: "memory");
        }
#pragma unroll
        for (int b = 0; b < 33; ++b) red[(F.wave * 33 + b) * 64 + F.lane] = acc[b];
        __syncthreads();
        for (int o = F.tid; o < 33 * 64; o += NTHR) { const int b = o >> 6, n = o & 63; float s = ada_b[l * NMODC + n0 + n];
#pragma unroll
            for (int w = 0; w < 8; ++w) s += red[(w * 33 + b) * 64 + n];
            MOD[((size_t)l * 33 + b) * NMODC + n0 + n] = s; }
        __syncthreads();
    }
}
__device__ __forceinline__ void p0_rope(Ctx& F) {
    float* CS = (float*)(F.ws + WS_ROPE); float* SN = CS + SEQ * 64;
    for (int i = F.bid * NTHR + F.tid; i < SEQ * 64; i += F.G * NTHR) {
        const int t = i >> 6, ax = (i >> 5) & 1, p = i & 31;
        const float pos = (float)(ax == 0 ? (t >> 6) : (t & 63));
        const float inv = powf(10000.0f, -(float)p / 32.0f);
        const float ang = pos * inv;
        CS[i] = cosf(ang); SN[i] = sinf(ang);
    }
}
template <int MODE>
__device__ __forceinline__ void row_pass(Ctx& F, const float* xin, const float* ctxin, int rbeg, int M, int vbid, int vG, const float* g, const float* bta, const float* MODl, int shift_idx, int scale_idx) {
    constexpr int RP = 4;
    const _Float16* Z = (const _Float16*)(F.ws + WS_H); bf16_t* XM = (bf16_t*)(F.ws + WS_XM);
    const int gw = vbid * NWAVES + F.wave, NGW = vG * NWAVES;
    for (int row0 = rbeg + gw * RP; row0 < M; row0 += NGW * RP) {
        float v[RP][2][8];
#pragma unroll
        for (int r = 0; r < RP; ++r) { const int row = row0 + r;
#pragma unroll
            for (int j = 0; j < 2; ++j) { const int col = 8 * F.lane + 512 * j;
                if (MODE == 0) { const float* src = (row < ML ? xin + (size_t)row * DM : ctxin + (size_t)(row - ML) * DM) + col; const f32x4 a = *(const f32x4*)src, b = *(const f32x4*)(src + 4);
#pragma unroll
                    for (int e = 0; e < 4; ++e) { v[r][j][e] = a[e]; v[r][j][4 + e] = b[e]; } }
                else { const h16x8 zz = *(const h16x8*)(Z + (size_t)row * DM + col);
#pragma unroll
                    for (int e = 0; e < 8; ++e) v[r][j][e] = (float)zz[e]; } } }
        if (MODE != 0) {
            float s[RP], s2[RP], mean[RP], rstd[RP];
#pragma unroll
            for (int r = 0; r < RP; ++r) { s[r] = 0.f;
#pragma unroll
                for (int j = 0; j < 2; ++j)
#pragma unroll
                    for (int e = 0; e < 8; ++e) s[r] += v[r][j][e]; }
#pragma unroll
            for (int o = 1; o < 64; o <<= 1) {
#pragma unroll
                for (int r = 0; r < RP; ++r) s[r] += __shfl_xor(s[r], o); }
#pragma unroll
            for (int r = 0; r < RP; ++r) { mean[r] = s[r] * (1.f / DM); s2[r] = 0.f;
#pragma unroll
                for (int j = 0; j < 2; ++j)
#pragma unroll
                    for (int e = 0; e < 8; ++e) { v[r][j][e] -= mean[r]; s2[r] += v[r][j][e] * v[r][j][e]; } }
#pragma unroll
            for (int o = 1; o < 64; o <<= 1) {
#pragma unroll
                for (int r = 0; r < RP; ++r) s2[r] += __shfl_xor(s2[r], o); }
#pragma unroll
            for (int r = 0; r < RP; ++r) { rstd[r] = 1.f / sqrtf(s2[r] * (1.f / DM) + LN_EPS);
                if (MODE == 1 && F.lane == 0) { float* st = (float*)(F.ws + WS_STATS) + 2 * (size_t)(row0 + r); st[0] = mean[r]; st[1] = rstd[r]; } }
#pragma unroll
            for (int j = 0; j < 2; ++j) { const int col = 8 * F.lane + 512 * j; const f32x4 ga = *(const f32x4*)(g + col), gb = *(const f32x4*)(g + col + 4), ba = *(const f32x4*)(bta + col), bb = *(const f32x4*)(bta + col + 4);
#pragma unroll
                for (int r = 0; r < RP; ++r)
#pragma unroll
                    for (int e = 0; e < 4; ++e) { v[r][j][e] = v[r][j][e] * rstd[r] * ga[e] + ba[e]; v[r][j][4 + e] = v[r][j][4 + e] * rstd[r] * gb[e] + bb[e]; } }
        }
        if (MODE == 2) {
#pragma unroll
            for (int r = 0; r < RP; ++r)
#pragma unroll
                for (int j = 0; j < 2; ++j) { float* o = F.out + (size_t)(row0 + r) * DM + 8 * F.lane + 512 * j;
                    *(f32x4*)o = (f32x4){v[r][j][0], v[r][j][1], v[r][j][2], v[r][j][3]}; *(f32x4*)(o + 4) = (f32x4){v[r][j][4], v[r][j][5], v[r][j][6], v[r][j][7]}; }
        } else {
            const int bi = row0 < ML ? (row0 >> 11) : NB;
            const float* mb = MODl + (size_t)bi * NMODC;
#pragma unroll
            for (int j = 0; j < 2; ++j) { const int col = 8 * F.lane + 512 * j;
                const f32x4 sha = *(const f32x4*)(mb + shift_idx * DM + col), shb = *(const f32x4*)(mb + shift_idx * DM + col + 4), sca = *(const f32x4*)(mb + scale_idx * DM + col), scb = *(const f32x4*)(mb + scale_idx * DM + col + 4);
#pragma unroll
                for (int r = 0; r < RP; ++r) { float y[8];
#pragma unroll
                    for (int e = 0; e < 4; ++e) { y[e] = v[r][j][e] * (sca[e] + 1.f) + sha[e]; y[4 + e] = v[r][j][4 + e] * (scb[e] + 1.f) + shb[e]; }
                    v4u w; w.x = cvtpk(y[0], y[1]); w.y = cvtpk(y[2], y[3]); w.z = cvtpk(y[4], y[5]); w.w = cvtpk(y[6], y[7]);
                    *(v4u*)(XM + (size_t)(row0 + r) * DM + col) = w; } }
        }
    }
}
__device__ __forceinline__ void qknorm_rope(Ctx& F, const float* qg, const float* kg) {
    bf16_t* Q = (bf16_t*)(F.ws + WS_Q); bf16_t* Kb = (bf16_t*)(F.ws + WS_K);
    const float* CS = (const float*)(F.ws + WS_ROPE); const float* SN = CS + SEQ * 64;
    const int gw = F.bid * NWAVES + F.wave, NGW = F.G * NWAVES;
    const int grp = F.lane >> 4, j = F.lane & 15, half = (j >> 2) & 1;
    float gq[8], gk[8];
#pragma unroll
    for (int e = 0; e < 8; ++e) { gq[e] = qg[8 * j + e]; gk[e] = kg[8 * j + e]; }
    for (int it = gw; it < MT / 4; it += NGW) {
        const int row = it * 4 + grp; const bool lat = row < ML;
        const int kvr = lat ? (row >> 11) * KVS + (row & 2047) : ((row - ML) >> 8) * KVS + SEQ + ((row - ML) & 255);
        float cs[8], sn[8];
        if (lat) { const int t = row & 2047; const float* cp = CS + t * 64 + (j >> 3) * 32 + (j & 3) * 8; const float* sp = SN + t * 64 + (j >> 3) * 32 + (j & 3) * 8;
#pragma unroll
            for (int e = 0; e < 8; ++e) { cs[e] = cp[e]; sn[e] = half ? sp[e] : -sp[e]; } }
        else {
#pragma unroll
            for (int e = 0; e < 8; ++e) { cs[e] = 1.f; sn[e] = 0.f; } }
        v4u win[10];
#pragma unroll
        for (int hh = 8; hh < 10; ++hh) win[hh] = *(const v4u*)(hh < 8 ? Q + (size_t)row * DM + hh * 128 + 8 * j : Kb + (size_t)kvr * 256 + (hh - 8) * 128 + 8 * j);
#pragma unroll
        for (int hh = 8; hh < 10; ++hh) {
            bf16_t* p = hh < 8 ? Q + (size_t)row * DM + hh * 128 + 8 * j : Kb + (size_t)kvr * 256 + (hh - 8) * 128 + 8 * j;
            const v4u w = win[hh];
            float x[8] = {bflo(w.x), bfhi(w.x), bflo(w.y), bfhi(w.y), bflo(w.z), bfhi(w.z), bflo(w.w), bfhi(w.w)};
            float ss = 0.f;
#pragma unroll
            for (int e = 0; e < 8; ++e) ss += x[e] * x[e];
            ss += __shfl_xor(ss, 1); ss += __shfl_xor(ss, 2); ss += __shfl_xor(ss, 4); ss += __shfl_xor(ss, 8);
            const float r = 1.f / sqrtf(ss * (1.f / 128.f) + RMS_EPS);
            float y[8];
#pragma unroll
            for (int e = 0; e < 8; ++e) { y[e] = x[e] * r * (hh < 8 ? gq[e] : gk[e]); }
#pragma unroll
            for (int e = 0; e < 8; ++e) { const float py = __shfl_xor(y[e], 4); x[e] = y[e] * cs[e] + py * sn[e]; }
            v4u o; o.x = cvtpk(x[0], x[1]); o.y = cvtpk(x[2], x[3]); o.z = cvtpk(x[4], x[5]); o.w = cvtpk(x[6], x[7]);
            *(v4u*)p = o;
        }
    }
}
__device__ __forceinline__ void attn_phase(Ctx& F, const float* qg) {
    bf16_t* Q = (bf16_t*)(F.ws + WS_Q); const attn::bf16* Kb = (const attn::bf16*)(F.ws + WS_K); const attn::bf16* Vb = (const attn::bf16*)(F.ws + WS_V);
    for (int uid = F.bid; uid < 2048 + 256; uid += F.G) {
        int row0, kv0, h, seq;
        if (uid < 2048) { const int g = uid & 3, qb = (uid >> 2) & 7, kvh = (uid >> 5) & 1, b = uid >> 6; h = kvh * 4 + g; row0 = b * SEQ + qb * 256; kv0 = b * KVS; seq = KVS; }
        else { const int u2 = uid - 2048; h = u2 & 7; const int b = u2 >> 3; row0 = ML + b * CTXL; kv0 = b * KVS + SEQ; seq = CTXL; }
        const int kvh = h >> 2;
        const float* cs_u = uid < 2048 ? (const float*)(F.ws + WS_ROPE) + (size_t)(row0 & 2047) * 64 : nullptr; const float* sn_u = cs_u ? cs_u + SEQ * 64 : nullptr;
        attn::attn_dense_body<attn::bf16>((const attn::bf16*)(Q + (size_t)row0 * DM + h * 128), Kb + (size_t)kv0 * 256 + kvh * 128, Vb + (size_t)kv0 * 256 + kvh * 128,
                                          Q + (size_t)row0 * DM + h * 128, seq, F.ldsg, qg, cs_u, sn_u);
        __syncthreads();
    }
}
namespace ml {
constexpr int LDQ = 272, LDT = 144;
constexpr int OFF_QS = 0, OFF_QW = 17408, OFF_KS = 34816, OFF_KWT = 52224, OFF_VT = 70656, OFF_SW = 107520, OFF_VEC = 116736;
constexpr int VEC_STRIDE = 1296, OFF_RDN = OFF_VEC + 2 * VEC_STRIDE, OFF_N = OFF_RDN + 256, OFF_CW = OFF_N + 512, LDS_END = OFF_CW + 4096;
static_assert(LDS_END <= 131072, "mlstm lds");
__device__ __forceinline__ int crow(int r, int hi) { return (r & 3) + 8 * (r >> 2) + 4 * hi; }
}
__device__ __forceinline__ void mlstm_scan(Ctx& F, bf16_t* HD, const float* conv_w, const float* conv_b) {
    using namespace ml;
    const bf16_t* P = (const bf16_t*)(F.ws + WS_BIG); const float* G = (const float*)(F.ws + WS_G);
    LAS unsigned char* L = F.lds;
    const int w = F.wave;
    for (int unit = F.bid; unit < 256; unit += F.G) {
        const int b = unit >> 3, h = (unit >> 1) & 3, dir0 = unit & 1;
        f32x16 Cst[4];
#pragma unroll
        for (int dt = 0; dt < 4; ++dt)
#pragma unroll
            for (int r = 0; r < 16; ++r) Cst[dt][r] = 0.f;
        float nreg = 0.f, mst = 0.f;
        if (F.tid < 128) ((LAS float*)(L + OFF_N))[F.tid] = 0.f;
        for (int i = F.tid; i < 1024; i += NTHR) { const int j = i & 3, ci = i >> 2; const int ch = (ci < 128 ? 0 : 512 - 128) + h * 128 + ci;
            ((LAS float*)(L + OFF_CW))[i] = j < 3 ? conv_w[j * 1024 + ch] : conv_b[ch]; }
        __syncthreads();
        v4u pq[4], ph[4], pv[4]; float pig = 0.f, pfg = 0.f;
#define ML_GEOM(cx, isctx_, rowbase_, t0_, Lseq_) const bool isctx_ = (cx) < 4; const int cc_##isctx_ = isctx_ ? (dir0 ? 3 - (cx) : (cx)) : (dir0 ? 31 - ((cx) - 4) : ((cx) - 4)); \
            const int rowbase_ = isctx_ ? ML + b * CTXL + 64 * cc_##isctx_ : b * SEQ + 64 * cc_##isctx_; const int t0_ = 64 * cc_##isctx_, Lseq_ = isctx_ ? CTXL : SEQ;
#define ML_PREFETCH(cx) do { ML_GEOM(cx, ic_, rb_, tz_, ls_) int ln_ = F.lane; asm volatile("" : "+v"(ln_)); \
            const bf16_t* prow_ = P + (size_t)(rb_ + ln_) * PLD; int hr_ = ln_ < 32 ? rb_ - 1 : rb_ + 64; if (tz_ == 0 && ln_ < 32) hr_ = rb_; if (tz_ + 64 >= ls_ && ln_ >= 32) hr_ = rb_ + 63; \
            const bf16_t* hrow_ = P + (size_t)hr_ * PLD; \
            if (!(ic_ && w < 4)) { const int cb_ = (w < 4 ? 0 : 512) + h * 128 + 32 * (w & 3); \
                _Pragma("unroll") for (int g8 = 0; g8 < 4; ++g8) { pq[g8] = *(const v4u*)(prow_ + cb_ + 8 * g8); ph[g8] = *(const v4u*)(hrow_ + cb_ + 8 * g8); } } \
            _Pragma("unroll") for (int g8 = 0; g8 < 4; ++g8) pv[g8] = *(const v4u*)(prow_ + 1024 + h * 256 + 32 * w + 8 * g8); \
            } while (0)
#define ML_GATELOAD(cx) do { ML_GEOM(cx, ig_, rg_, tg_, lg_) (void)tg_; (void)lg_; int ln_ = F.lane; asm volatile("" : "+v"(ln_)); const int ti_ = dir0 ? 63 - ln_ : ln_; \
            const float* gp_ = G + (size_t)(rg_ + ti_) * 16; pig = gp_[(2 * dir0) * 4 + h]; pfg = gp_[(2 * dir0 + 1) * 4 + h]; } while (0)
#define ML_GATES(cx) do { LAS float* vg_ = (LAS float*)(L + OFF_VEC + ((cx) & 1) * VEC_STRIDE); int ln_ = F.lane; asm volatile("" : "+v"(ln_)); const int ti_ = dir0 ? 63 - ln_ : ln_; \
            const float fl_ = fminf(pfg, 0.f) - log1pf(expf(-fabsf(pfg))); float bc_ = fl_; \
            _Pragma("unroll") for (int o = 1; o < 64; o <<= 1) { const float t_ = __shfl_up(bc_, o); if (ln_ >= o) bc_ += t_; } \
            const float a_ = pig - bc_; float pm_ = a_; \
            _Pragma("unroll") for (int o = 1; o < 64; o <<= 1) { const float t_ = __shfl_up(pm_, o); if (ln_ >= o) pm_ = fmaxf(pm_, t_); } \
            const float M_ = fmaxf(mst, pm_); const float Ml_ = __shfl(M_, 63), bl_ = __shfl(bc_, 63); \
            vg_[ti_] = a_; vg_[64 + ti_] = M_; vg_[128 + ti_] = expf(mst - M_); vg_[192 + ti_] = bc_ + M_; vg_[256 + ti_] = expf(a_ - Ml_); \
            if (ln_ == 0) vg_[320] = expf(mst - Ml_); \
            mst = bl_ + Ml_; } while (0)
        ML_PREFETCH(0);
        if (w == 4) { ML_GATELOAD(0); ML_GATES(0); ML_GATELOAD(1); }
#define ML_LBAR() do { asm volatile("s_waitcnt lgkmcnt(0)" ::: "memory"); __builtin_amdgcn_s_barrier(); asm volatile("" ::: "memory"); } while (0)
        ML_LBAR();
        for (int c = 0; c < 36; ++c) {
            ML_GEOM(c, isctx, rowbase, t0, Lseq)
            LAS float* vec = (LAS float*)(L + OFF_VEC + (c & 1) * VEC_STRIDE);
            int lane_c = F.lane, dir_c = dir0; asm volatile("" : "+v"(lane_c), "+s"(dir_c));
            const int lane = lane_c, r32 = lane & 31, hi = lane >> 5, dir = dir_c;
            {
                const int ti = lane, t = t0 + ti;
                const bool hasp = t >= 1, hasn = t + 1 < Lseq;
                const float wi = vec[128 + ti], wk = vec[256 + ti];
                if (!(isctx && w < 4)) {
                    const bool isq = w < 4; const int dbase = 32 * (w & 3);
#pragma unroll
                    for (int g8 = 0; g8 < 4; ++g8) {
                        const v4u cur = pq[g8], hal = ph[g8];
                        v4u prv, nxt;
                        prv.x = __shfl_up(cur.x, 1); prv.y = __shfl_up(cur.y, 1); prv.z = __shfl_up(cur.z, 1); prv.w = __shfl_up(cur.w, 1);
                        nxt.x = __shfl_down(cur.x, 1); nxt.y = __shfl_down(cur.y, 1); nxt.z = __shfl_down(cur.z, 1); nxt.w = __shfl_down(cur.w, 1);
                        if (lane == 0) prv = hal;
                        if (lane == 63) nxt = hal;
                        if (!hasp) prv = (v4u){0u, 0u, 0u, 0u};
                        if (!hasn) nxt = (v4u){0u, 0u, 0u, 0u};
                        float y[8];
#pragma unroll
                        for (int e2 = 0; e2 < 4; ++e2) {
                            const unsigned pc = e2 == 0 ? prv.x : e2 == 1 ? prv.y : e2 == 2 ? prv.z : prv.w;
                            const unsigned cu = e2 == 0 ? cur.x : e2 == 1 ? cur.y : e2 == 2 ? cur.z : cur.w;
                            const unsigned nx = e2 == 0 ? nxt.x : e2 == 1 ? nxt.y : e2 == 2 ? nxt.z : nxt.w;
                            const LAS f32x4* cw = (const LAS f32x4*)(L + OFF_CW) + (isq ? 0 : 128) + dbase + 8 * g8 + 2 * e2;
                            const f32x4 ca = cw[0], cb = cw[1];
                            y[2 * e2] = ca[0] * bflo(pc) + ca[1] * bflo(cu) + ca[2] * bflo(nx) + ca[3];
                            y[2 * e2 + 1] = cb[0] * bfhi(pc) + cb[1] * bfhi(cu) + cb[2] * bfhi(nx) + cb[3];
                        }
#pragma unroll
                        for (int e = 0; e < 8; ++e) y[e] = siluf(y[e]);
                        const int dd = dbase + 8 * g8;
                        if (isq) {
                            v4u o; o.x = cvtpk(y[0], y[1]); o.y = cvtpk(y[2], y[3]); o.z = cvtpk(y[4], y[5]); o.w = cvtpk(y[6], y[7]);
                            *(LAS v4u*)(L + OFF_QS + ti * LDQ + dd * 2) = o;
                            o.x = cvtpk(y[0] * wi, y[1] * wi); o.y = cvtpk(y[2] * wi, y[3] * wi); o.z = cvtpk(y[4] * wi, y[5] * wi); o.w = cvtpk(y[6] * wi, y[7] * wi);
                            *(LAS v4u*)(L + OFF_QW + ti * LDQ + dd * 2) = o;
                        } else {
#pragma unroll
                            for (int e = 0; e < 8; ++e) y[e] *= 0.08838834764831845f;
                            v4u o; o.x = cvtpk(y[0], y[1]); o.y = cvtpk(y[2], y[3]); o.z = cvtpk(y[4], y[5]); o.w = cvtpk(y[6], y[7]);
                            *(LAS v4u*)(L + OFF_KS + ti * LDQ + dd * 2) = o;
#pragma unroll
                            for (int e = 0; e < 8; ++e) *(LAS unsigned short*)(L + OFF_KWT + (dd + e) * LDT + ti * 2) = (unsigned short)(cvtpk(y[e] * wk, 0.f) & 0xffffu);
                        }
                    }
                }
#pragma unroll
                for (int g8 = 0; g8 < 4; ++g8) {
                    const int vv = 32 * w + 8 * g8;
                    const v4u cur = pv[g8];
                    const unsigned ws4[4] = {cur.x, cur.y, cur.z, cur.w};
#pragma unroll
                    for (int e2 = 0; e2 < 4; ++e2) {
                        *(LAS unsigned short*)(L + OFF_VT + (vv + 2 * e2) * LDT + ti * 2) = (unsigned short)(ws4[e2] & 0xffffu);
                        *(LAS unsigned short*)(L + OFF_VT + (vv + 2 * e2 + 1) * LDT + ti * 2) = (unsigned short)(ws4[e2] >> 16);
                    }
                }
                if (c + 1 < 36) ML_PREFETCH(c + 1);
            }
            ML_LBAR();
            if (w == 4 && c + 1 < 36) { ML_GATES(c + 1); if (c + 2 < 36) ML_GATELOAD(c + 2); }
            if (!isctx) {
                if (w < 4) {
                    const int st = w & 1, tt = w >> 1;
                    f32x16 acc;
#pragma unroll
                    for (int r = 0; r < 16; ++r) acc[r] = 0.f;
                    const LAS unsigned char* ap = L + OFF_KS + (32 * st + r32) * LDQ + hi * 16;
                    const LAS unsigned char* bp = L + OFF_QS + (32 * tt + r32) * LDQ + hi * 16;
#pragma unroll
                    for (int ks = 0; ks < 8; ++ks) acc = __builtin_amdgcn_mfma_f32_32x32x16_bf16(*(const LAS bf16x8*)(ap + ks * 32), *(const LAS bf16x8*)(bp + ks * 32), acc, 0, 0, 0);
                    const int t = 32 * tt + r32, jt = dir ? 63 - t : t; const float Mt = vec[64 + t];
#pragma unroll
                    for (int q = 0; q < 4; ++q) {
                        float vals[4];
#pragma unroll
                        for (int e = 0; e < 4; ++e) { const int s = 32 * st + 8 * q + 4 * hi + e, js = dir ? 63 - s : s;
                            const float wgt = js <= jt ? __expf(vec[s] - Mt) : 0.f; vals[e] = acc[4 * q + e] * wgt; }
                        v2u o; o.x = cvtpk(vals[0], vals[1]); o.y = cvtpk(vals[2], vals[3]);
                        *(LAS v2u*)(L + OFF_SW + t * LDT + (32 * st + 8 * q + 4 * hi) * 2) = o;
                    }
                }
                ML_LBAR();
                {
                    const int t = F.tid >> 3, p = F.tid & 7;
                    const v4u sw = *(const LAS v4u*)(L + OFF_SW + t * LDT + 16 * p);
                    float d = (bflo(sw.x) + bfhi(sw.x)) + (bflo(sw.y) + bfhi(sw.y)) + (bflo(sw.z) + bfhi(sw.z)) + (bflo(sw.w) + bfhi(sw.w));
                    const LAS float* nl = (const LAS float*)(L + OFF_N) + 16 * p;
#pragma unroll
                    for (int hq = 0; hq < 2; ++hq) { const v4u qw = *(const LAS v4u*)(L + OFF_QW + t * LDQ + 32 * p + 16 * hq); const LAS float* n8 = nl + 8 * hq;
                        d += bflo(qw.x) * n8[0] + bfhi(qw.x) * n8[1] + bflo(qw.y) * n8[2] + bfhi(qw.y) * n8[3] + bflo(qw.z) * n8[4] + bfhi(qw.z) * n8[5] + bflo(qw.w) * n8[6] + bfhi(qw.w) * n8[7]; }
                    d += __shfl_xor(d, 1); d += __shfl_xor(d, 2); d += __shfl_xor(d, 4);
                    if (p == 0) ((LAS float*)(L + OFF_RDN))[t] = 1.f / fmaxf(fabsf(d), expf(-vec[192 + t]));
                }
                ML_LBAR();
                bf16x8 Cb[4][2];
#pragma unroll
                for (int dt = 0; dt < 4; ++dt)
#pragma unroll
                    for (int jp = 0; jp < 2; ++jp) { v4u o; o.x = cvtpk(Cst[dt][8 * jp + 0], Cst[dt][8 * jp + 1]); o.y = cvtpk(Cst[dt][8 * jp + 2], Cst[dt][8 * jp + 3]);
                        o.z = cvtpk(Cst[dt][8 * jp + 4], Cst[dt][8 * jp + 5]); o.w = cvtpk(Cst[dt][8 * jp + 6], Cst[dt][8 * jp + 7]); Cb[dt][jp] = __builtin_bit_cast(bf16x8, o); }
                const LAS unsigned char* vtp = L + OFF_VT + (32 * w + r32) * LDT + hi * 16;
#pragma unroll
                for (int tt = 0; tt < 2; ++tt) {
                    f32x16 acc;
#pragma unroll
                    for (int r = 0; r < 16; ++r) acc[r] = 0.f;
                    const LAS unsigned char* swp = L + OFF_SW + (32 * tt + r32) * LDT + hi * 16;
#pragma unroll
                    for (int ks = 0; ks < 4; ++ks) acc = __builtin_amdgcn_mfma_f32_32x32x16_bf16(*(const LAS bf16x8*)(vtp + ks * 32), *(const LAS bf16x8*)(swp + ks * 32), acc, 0, 0, 0);
                    const LAS unsigned char* qwp = L + OFF_QW + (32 * tt + r32) * LDQ + hi * 8;
#pragma unroll
                    for (int dt = 0; dt < 4; ++dt)
#pragma unroll
                        for (int jp = 0; jp < 2; ++jp) {
                            const v2u lo = *(const LAS v2u*)(qwp + (32 * dt + 16 * jp) * 2), hi2 = *(const LAS v2u*)(qwp + (32 * dt + 16 * jp + 8) * 2);
                            v4u bv; bv.x = lo.x; bv.y = lo.y; bv.z = hi2.x; bv.w = hi2.y;
                            acc = __builtin_amdgcn_mfma_f32_32x32x16_bf16(Cb[dt][jp], __builtin_bit_cast(bf16x8, bv), acc, 0, 0, 0);
                        }
                    const int t = 32 * tt + r32; const float rdn_t = ((const LAS float*)(L + OFF_RDN))[t];
                    bf16_t* hrow = HD + ((size_t)dir * ML + rowbase + t) * DM + h * 256 + 32 * w + 4 * hi;
#pragma unroll
                    for (int q = 0; q < 4; ++q) { v2u o; o.x = cvtpk(acc[4 * q] * rdn_t, acc[4 * q + 1] * rdn_t); o.y = cvtpk(acc[4 * q + 2] * rdn_t, acc[4 * q + 3] * rdn_t);
                        *(v2u*)(hrow + 8 * q) = o; }
                }
            }
            {
                const float decay = vec[320];
                const LAS unsigned char* vtp = L + OFF_VT + (32 * w + r32) * LDT + hi * 16;
                bf16x8 vb[4];
#pragma unroll
                for (int ks = 0; ks < 4; ++ks) vb[ks] = *(const LAS bf16x8*)(vtp + ks * 32);
#pragma unroll
                for (int dt = 0; dt < 4; ++dt) {
#pragma unroll
                    for (int r = 0; r < 16; ++r) Cst[dt][r] *= decay;
                    const LAS unsigned char* kp = L + OFF_KWT + (32 * dt + r32) * LDT + hi * 16;
#pragma unroll
                    for (int ks = 0; ks < 4; ++ks) Cst[dt] = __builtin_amdgcn_mfma_f32_32x32x16_bf16(*(const LAS bf16x8*)(kp + ks * 32), vb[ks], Cst[dt], 0, 0, 0);
                }
                if (F.tid < 128) {
                    float s = 0.f;
#pragma unroll
                    for (int i = 0; i < 8; ++i) { const v4u kw = *(const LAS v4u*)(L + OFF_KWT + F.tid * LDT + 16 * i);
                        s += (bflo(kw.x) + bfhi(kw.x)) + (bflo(kw.y) + bfhi(kw.y)) + (bflo(kw.z) + bfhi(kw.z)) + (bflo(kw.w) + bfhi(kw.w)); }
                    nreg = decay * nreg + s;
                    ((LAS float*)(L + OFF_N))[F.tid] = nreg;
                }
            }
            ML_LBAR();
        }
        __syncthreads();
    }
}
__device__ __forceinline__ void mlstm_readout(Ctx& F, const bf16_t* HD, const float* ng) {
    const bf16_t* P = (const bf16_t*)(F.ws + WS_BIG); bf16_t* A2 = (bf16_t*)(F.ws + WS_XM);
    const int gw = F.bid * NWAVES + F.wave, NGW = F.G * NWAVES;
    constexpr int RP = 2;
    for (int row0 = gw * RP; row0 < ML; row0 += NGW * RP) {
        const int col = 16 * F.lane;
        v4u ra[RP][2], rb[RP][2], ro[RP][2];
#pragma unroll
        for (int r = 0; r < RP; ++r)
#pragma unroll
            for (int i = 0; i < 2; ++i) { const int row = row0 + r;
                ra[r][i] = *(const v4u*)(HD + (size_t)row * DM + col + 8 * i); rb[r][i] = *(const v4u*)(HD + ((size_t)ML + row) * DM + col + 8 * i); ro[r][i] = *(const v4u*)(P + (size_t)row * PLD + 2048 + col + 8 * i); }
        float ngv[16];
#pragma unroll
        for (int e = 0; e < 16; ++e) ngv[e] = ng[col + e];
#pragma unroll
        for (int r = 0; r < RP; ++r) {
            const int row = row0 + r;
            float s[16], o[16];
#pragma unroll
            for (int i = 0; i < 2; ++i) {
                const unsigned aw[4] = {ra[r][i].x, ra[r][i].y, ra[r][i].z, ra[r][i].w}, bw[4] = {rb[r][i].x, rb[r][i].y, rb[r][i].z, rb[r][i].w}, ow[4] = {ro[r][i].x, ro[r][i].y, ro[r][i].z, ro[r][i].w};
#pragma unroll
                for (int e = 0; e < 4; ++e) { s[8 * i + 2 * e] = bflo(aw[e]) + bflo(bw[e]); s[8 * i + 2 * e + 1] = bfhi(aw[e]) + bfhi(bw[e]); o[8 * i + 2 * e] = bflo(ow[e]); o[8 * i + 2 * e + 1] = bfhi(ow[e]); }
            }
            float sum = 0.f;
#pragma unroll
            for (int e = 0; e < 16; ++e) sum += s[e];
            sum += __shfl_xor(sum, 1); sum += __shfl_xor(sum, 2); sum += __shfl_xor(sum, 4); sum += __shfl_xor(sum, 8);
            const float mu = sum * (1.f / 256.f); float q = 0.f;
#pragma unroll
            for (int e = 0; e < 16; ++e) { s[e] -= mu; q += s[e] * s[e]; }
            q += __shfl_xor(q, 1); q += __shfl_xor(q, 2); q += __shfl_xor(q, 4); q += __shfl_xor(q, 8);
            const float rstd = 1.f / sqrtf(q * (1.f / 256.f) + LN_EPS);
            float y[16];
#pragma unroll
            for (int e = 0; e < 16; ++e) y[e] = s[e] * rstd * ngv[e] * __builtin_amdgcn_rcpf(1.f + __expf(-o[e]));
#pragma unroll
            for (int i = 0; i < 2; ++i) { v4u wv; wv.x = cvtpk(y[8 * i], y[8 * i + 1]); wv.y = cvtpk(y[8 * i + 2], y[8 * i + 3]); wv.z = cvtpk(y[8 * i + 4], y[8 * i + 5]); wv.w = cvtpk(y[8 * i + 6], y[8 * i + 7]);
                *(v4u*)(A2 + (size_t)row * DM + col + 8 * i) = wv; }
        }
    }
}
constexpr int N_PHASES = 24;

template <class Epi>
__device__ __forceinline__ void run_gemm(Ctx& F, const bf16_t* A, const bf16_t* Bt, int M, int N, int K, const Epi& E, int rev = 0, int vG = 0, int pm_off = 0, unsigned long long pn_map = 0ull) {
    pg8::Gemm g{A, Bt, M + pm_off * 256, N, K}; pg8::StaticOrder S; S.init(M, N, vG ? vG : F.G, F.bid, rev, pm_off); S.pn_map = pn_map;
    pg8::gemm_phase<Epi, pg8::StaticOrder, true, true>(F.lds, g, S, E);
}
template <class Epi>
__device__ __forceinline__ void run_gemm_tail(Ctx& F, const bf16_t* A, const bf16_t* Bt, int M, int N, int K, const Epi& E, int ext_units, int ext_rows, int ext_pm0, unsigned long long ext_map) {
    pg8::Gemm g{A, Bt, M, N, K}; pg8::StaticOrder S; S.init(M, N, F.G, F.bid, 0, 0); S.ext_units = ext_units; S.ext_rows = ext_rows; S.ext_pm0 = ext_pm0; S.ext_map = ext_map;
    pg8::gemm_phase<Epi, pg8::StaticOrder, true, true>(F.lds, g, S, E);
}
__device__ __forceinline__ void grid_barrier(Ctx& F) {
    relane(F); XcdBarrier xb_; xb_.bar = (unsigned*)(F.ws + WS_CTL); xb_.x = xb_xcc_id(); xb_.st = (volatile LAS unsigned*)(F.lds + XB_LDS_OFF); xcd_barrier(xb_);
}
template <class Epi>
__device__ __forceinline__ void ffn2_rowpass(Ctx& F, const Epi& E, const bf16_t* W2t, const float* g, const float* bta, const float* MODx, int shift_idx, int scale_idx) {
    const bf16_t* HID = (const bf16_t*)(F.ws + WS_BIG);
    if (F.G != 256) {
        run_gemm(F, HID, W2t, MT, DM, DFF, E, 1); grid_barrier(F);
        relane(F); row_pass<1>(F, nullptr, nullptr, 0, MT, F.bid, F.G, g, bta, MODx, shift_idx, scale_idx); return; }
    constexpr int R1 = 57344;
    run_gemm(F, HID, W2t, ML, DM, DFF, E, 1);
    grid_barrier(F);
    if (F.bid < 128) run_gemm(F, HID, W2t, MC, DM, DFF, E, 0, 128, ML / 256);
    else row_pass<1>(F, nullptr, nullptr, 0, R1, F.bid - 128, 128, g, bta, MODx, shift_idx, scale_idx);
    grid_barrier(F);
    row_pass<1>(F, nullptr, nullptr, R1, MT, F.bid, F.G, g, bta, MODx, shift_idx, scale_idx);
}
#ifndef REP_FFN1
#define REP_FFN1 1
#endif
#ifndef REP_SCAN
#define REP_SCAN 1
#endif
#ifndef REP_XM0
#define REP_XM0 1
#endif
#ifndef PH_LO
#define PH_LO 0
#endif
#ifndef PH_HI
#define PH_HI N_PHASES
#endif
constexpr int lo = PH_LO, hi = PH_HI;
#ifndef CATS
#define CATS 0xff
#endif
#ifndef GSEL
#define GSEL 0xf
#endif
#define CAT_P0 ((CATS & 1) != 0)
#define CAT_ROW ((CATS & 2) != 0)
#define CAT_GEMM ((CATS & 4) != 0)
#define CAT_ATTN ((CATS & 8) != 0)
#define CAT_ML ((CATS & 16) != 0)
#define CAT_QKN ((CATS & 32) != 0)
#define IN(k) (lo <= (k) && (k) < hi)
#define SEAM(k) do { if (IN(k) && IN((k) + 1)) { grid_barrier(F); } } while (0)
#define H ((_Float16*)(F.ws + WS_H))
#define XM ((bf16_t*)(F.ws + WS_XM))
#define BIG ((bf16_t*)(F.ws + WS_BIG))
#define MOD ((const float*)(F.ws + WS_MOD))
#define ln_g ARG_IN(6)
#define ln_b ARG_IN(7)
#define STATS ((const float*)(F.ws + WS_STATS))

template <int l>
__device__ __forceinline__ void layer_body(Ctx& F) {

        const int pb = 2 + 11 * l;
#define MODl (MOD + (size_t)l * 33 * NMODC)
        const int Mmix = (l == 0) ? MT : ML;
        {
        if (CAT_GEMM && IN(pb + 0)) { relane(F); EpiSwiglu E{BIG}; if (GSEL & 1) run_gemm(F, XM, (const bf16_t*)(F.ws + WS_W1 + (size_t)(2 * l) * W1_SZ), MT, NFF1, DM, E); } }
        SEAM(pb + 0);
        if (CAT_GEMM && IN(pb + 1)) { relane(F);
            if (l == 0) { EpiResid<false, 1> E{ARG_IN(0), ARG_IN(2), H, MODl + 2 * DM, nullptr, nullptr, nullptr};
                ffn2_rowpass(F, E, (const bf16_t*)(F.ws + WS_W2 + (size_t)(2 * l) * W2_SZ), ln_g + (l * 3 + 0) * DM, ln_b + (l * 3 + 0) * DM, MODl, 3, 4); }
            else { EpiResid<true, 1> E{nullptr, nullptr, H, MODl + 2 * DM, STATS, ln_g + 2 * DM, ln_b + 2 * DM};
                ffn2_rowpass(F, E, (const bf16_t*)(F.ws + WS_W2 + (size_t)(2 * l) * W2_SZ), ln_g + (l * 3 + 0) * DM, ln_b + (l * 3 + 0) * DM, MODl, 3, 4); } }
        SEAM(pb + 2);
        if (l == 0) {
            if (CAT_GEMM && IN(pb + 3)) { relane(F); EpiQKV E{(bf16_t*)(F.ws + WS_Q), (bf16_t*)(F.ws + WS_K), (bf16_t*)(F.ws + WS_V)}; if (GSEL & 4) run_gemm(F, XM, (const bf16_t*)(F.ws + WS_WQKV), MT, NQKV, DM, E); }
            SEAM(pb + 3);
            if (CAT_QKN && IN(pb + 4)) relane(F), qknorm_rope(F, ARG_IN(11), ARG_IN(12));
            SEAM(pb + 4);
            if (CAT_ATTN && IN(pb + 5)) { relane(F); attn_phase(F, ARG_IN(11)); }
            SEAM(pb + 5);
            if (CAT_GEMM && IN(pb + 6)) { relane(F); EpiResid<true, 2> E{nullptr, nullptr, H, MODl + 5 * DM, STATS, ln_g + (l * 3 + 0) * DM, ln_b + (l * 3 + 0) * DM}; if (GSEL & 2) run_gemm(F, (const bf16_t*)(F.ws + WS_Q), (const bf16_t*)(F.ws + WS_WOA), MT, DM, DM, E); }
            SEAM(pb + 6);
        } else {
            bf16_t* HD = (bf16_t*)F.out;
            if (CAT_GEMM && IN(pb + 3)) { relane(F); EpiMlIn E{BIG, (float*)(F.ws + WS_G), ARG_IN(15)};
                run_gemm_tail(F, XM, (const bf16_t*)(F.ws + WS_WMI), ML, NMLPAD, DM, E, 7 * 32, 32, ML / 256, 0xC765432ull); }
            SEAM(pb + 3);
            {
            if (CAT_ML && IN(pb + 4)) relane(F), mlstm_scan(F, HD, ARG_IN(16), ARG_IN(17)); }
            SEAM(pb + 4);
            if (CAT_ML && IN(pb + 5)) relane(F), mlstm_readout(F, HD, ARG_IN(18));
            SEAM(pb + 5);
            if (CAT_GEMM && IN(pb + 6)) { relane(F); EpiResid<true, 2> E{nullptr, nullptr, H, MODl + 5 * DM, STATS, ln_g + (l * 3 + 0) * DM, ln_b + (l * 3 + 0) * DM}; if (GSEL & 2) run_gemm(F, XM, (const bf16_t*)(F.ws + WS_WMO), ML, DM, DM, E); }
            SEAM(pb + 6);
        }
        if (CAT_ROW && IN(pb + 7)) relane(F), row_pass<1>(F, nullptr, nullptr, 0, Mmix, F.bid, F.G, ln_g + (l * 3 + 1) * DM, ln_b + (l * 3 + 1) * DM, MODl, 6, 7);
        SEAM(pb + 7);
        if (CAT_GEMM && IN(pb + 8)) { relane(F); EpiSwiglu E{BIG}; if (GSEL & 1) run_gemm(F, XM, (const bf16_t*)(F.ws + WS_W1 + (size_t)(2 * l + 1) * W1_SZ), Mmix, NFF1, DM, E); }
        SEAM(pb + 8);
        if (l == 0) {
            if (CAT_GEMM && IN(pb + 9)) { relane(F); EpiResid<true, 1> E{nullptr, nullptr, H, MODl + 8 * DM, STATS, ln_g + (l * 3 + 1) * DM, ln_b + (l * 3 + 1) * DM};
                ffn2_rowpass(F, E, (const bf16_t*)(F.ws + WS_W2 + (size_t)(2 * l + 1) * W2_SZ), ln_g + 2 * DM, ln_b + 2 * DM, MOD + (size_t)33 * NMODC, 0, 1); }
        } else {
            if (CAT_GEMM && IN(pb + 9)) { relane(F); EpiResid<true, 1> E{nullptr, nullptr, H, MODl + 8 * DM, STATS, ln_g + (l * 3 + 1) * DM, ln_b + (l * 3 + 1) * DM}; run_gemm(F, BIG, (const bf16_t*)(F.ws + WS_W2 + (size_t)(2 * l + 1) * W2_SZ), Mmix, DM, DFF, E, 1); }
            SEAM(pb + 9);
            if (CAT_ROW && IN(pb + 10)) relane(F), row_pass<2>(F, nullptr, nullptr, 0, ML, F.bid, F.G, ln_g + 5 * DM, ln_b + 5 * DM, MODl, 0, 1);
        }
        SEAM(pb + 10);
}

__global__ void __launch_bounds__(NTHR, 2) fwd_megakernel(Args args) {
    extern __shared__ __attribute__((aligned(16))) unsigned char lds_raw[];
    cg::grid_group grid = cg::this_grid();
    Ctx F;
    F.lds = (LAS unsigned char*)lds_raw; F.ldsg = (char*)lds_raw;
    relane(F);
    if (F.tid < 64) ((LAS unsigned*)(F.lds + XB_LDS_OFF))[F.tid] = 0u;
    __syncthreads();
    if (karg_u64(176) == 0x1234567812345678ull) cg::this_grid().sync();
    (void)xcd_barrier_post((unsigned*)(F.ws + WS_CTL), (volatile LAS unsigned*)(F.lds + XB_LDS_OFF));
    if (CAT_P0 && IN(0)) { p0_weights(F, ARG_IN(8), ARG_IN(9), ARG_IN(10), ARG_IN(13), ARG_IN(14), ARG_IN(19)); __syncthreads(); p0_mods(F, ARG_IN(1), ARG_IN(3), ARG_IN(4), ARG_IN(5)); p0_rope(F); }
    SEAM(0);
    {
    if (CAT_ROW && IN(1)) relane(F), row_pass<0>(F, ARG_IN(0), ARG_IN(2), 0, MT, F.bid, F.G, nullptr, nullptr, MOD, 0, 1); }
    SEAM(1);
    layer_body<0>(F);
    layer_body<1>(F);
#undef H
#undef XM
#undef BIG
#undef MOD
#undef MODl
#undef ln_g
#undef ln_b
#undef STATS
#undef IN
#undef SEAM
}

extern "C" void kernel_launch(void* const* d_in, const int* in_sizes, int n_in, void* d_out, int out_size, void* d_ws, size_t ws_size, hipStream_t stream) {
    static int grid_blocks = 0;
    if (!grid_blocks) {
        if (n_in != 20 || out_size != ML * DM || ws_size < WS_END) { fprintf(stderr, "kernel_launch: unexpected shapes: n_in %d out %d ws %zu (need %zu)\n", n_in, out_size, ws_size, (size_t)WS_END); return; }
        int dev = 0, cus = 0, per_cu = 0;
        hipGetDevice(&dev);
        hipDeviceGetAttribute(&cus, hipDeviceAttributeMultiprocessorCount, dev);
        if (hipFuncSetAttribute((const void*)fwd_megakernel, hipFuncAttributeMaxDynamicSharedMemorySize, LDS_BYTES) != hipSuccess) { fprintf(stderr, "kernel_launch: hipFuncSetAttribute failed\n"); return; }
        hipOccupancyMaxActiveBlocksPerMultiprocessor(&per_cu, fwd_megakernel, NTHR, LDS_BYTES);
        if (per_cu < 1) { fprintf(stderr, "kernel_launch: occupancy query says 0 blocks per CU\n"); return; }
        grid_blocks = cus * 1;
    }
    if (hipMemsetAsync((char*)d_ws + WS_CTL, 0, XCD_BAR_WORDS * 4, stream) != hipSuccess) { fprintf(stderr, "kernel_launch: memset failed\n"); return; }
    Args a{};
    for (int i = 0; i < 20; ++i) a.in[i] = (const float*)d_in[i];
    a.out = (float*)d_out; a.ws = (unsigned char*)d_ws; a.ph_lo = 0; a.ph_hi = N_PHASES;
    void* kargs[] = {&a};
    hipError_t e = hipLaunchCooperativeKernel((const void*)fwd_megakernel, dim3(grid_blocks), dim3(NTHR), kargs, LDS_BYTES, stream);
    if (e != hipSuccess) fprintf(stderr, "cooperative launch failed: %s (grid %d)\n", hipGetErrorString(e), grid_blocks);
}
```
